# Optimizing an MI355X kernel written in HIP

```python
import math
import jax, jax.numpy as jnp
from jax import lax
import numpy as np

D_MODEL = 2048
BATCH = 16
SEQ = 2048
DEPTH = 1
DEC_BATCH = 2
DEC_SEQ = 16384
PAST_LEN = 128

MIX_WIDTH = D_MODEL
FOURIER_WIDTH = MIX_WIDTH // 2
FOURIER_GROUP = 128
N_FGROUPS = FOURIER_WIDTH // FOURIER_GROUP
ATTN_WIDTH = MIX_WIDTH - FOURIER_WIDTH
ATTN_HEAD = 128
N_HEADS = ATTN_WIDTH // ATTN_HEAD
HALF_DIM = ATTN_HEAD // 2
IN_WIDTH = FOURIER_WIDTH + 3 * ATTN_WIDTH
D_FF = ((8 * D_MODEL // 3 + 255) // 256) * 256
NUM_BUCKETS = 32
MAX_DISTANCE = 128
Q_BLOCK = 128
EPS = 1e-6

kernel_name = "hybrid_fnet_diffattn_encoder"


def rmsnorm(x, g):
    xf = x.astype(jnp.float32)
    y = xf * lax.rsqrt(jnp.mean(xf * xf, axis=-1, keepdims=True) + EPS)
    return (y * g.astype(jnp.float32)).astype(x.dtype)


def t5_bucket(rel):
    nb = NUM_BUCKETS // 2
    max_exact = nb // 2
    ret = (rel > 0).astype(jnp.int32) * nb
    n = jnp.abs(rel)
    nf = jnp.maximum(n, 1).astype(jnp.float32)
    large = max_exact + (jnp.log(nf / max_exact) / math.log(MAX_DISTANCE / max_exact)
                         * (nb - max_exact)).astype(jnp.int32)
    large = jnp.minimum(large, nb - 1)
    return ret + jnp.where(n < max_exact, n, large)


def fourier_mix(u, w_f):
    B, S, _ = u.shape
    ug = u.reshape(B, S, N_FGROUPS, FOURIER_GROUP).astype(jnp.float32)
    f = jnp.fft.fft2(ug, axes=(1, 3), norm="ortho").real
    y = jnp.einsum('bsgc,gce->bsge', f, w_f.astype(jnp.float32))
    return y.reshape(B, S, FOURIER_WIDTH).astype(u.dtype)


def diff_attention(q, k, v, lam, lam_init, subln_g, rel_bias):
    B, S = q.shape[0], q.shape[1]
    nblk = S // Q_BLOCK
    scale = HALF_DIM ** -0.5
    qb = q.reshape(B, nblk, Q_BLOCK, N_HEADS, 2, HALF_DIM).transpose(1, 0, 2, 3, 4, 5)
    starts = jnp.arange(nblk, dtype=jnp.int32) * Q_BLOCK
    kpos = jnp.arange(S, dtype=jnp.int32)
    kf = k.astype(jnp.float32)
    vf = v.astype(jnp.float32)
    table = rel_bias.astype(jnp.float32)

    def block(args):
        qi, start = args
        qpos = start + jnp.arange(Q_BLOCK, dtype=jnp.int32)
        bias = table[t5_bucket(kpos[None, :] - qpos[:, None])]
        bias = bias.transpose(2, 0, 1)
        s = jnp.einsum('bqhcd,bkhcd->bchqk', qi.astype(jnp.float32), kf) * scale
        p = jax.nn.softmax(s + bias[None, None], axis=-1)
        a = p[:, 0] - lam * p[:, 1]
        return jnp.einsum('bhqk,bkhe->bqhe', a, vf)

    o = lax.map(block, (qb, starts))
    o = o.transpose(1, 0, 2, 3, 4).reshape(B, S, N_HEADS, ATTN_HEAD)
    o = o * lax.rsqrt(jnp.mean(o * o, axis=-1, keepdims=True) + EPS) * subln_g.astype(jnp.float32)
    o = o * (1.0 - lam_init)
    return o.reshape(B, S, ATTN_WIDTH).astype(q.dtype)


def encoder(x, norm1_g, w_in, w_fourier, lambda_q1, lambda_k1, lambda_q2, lambda_k2,
            subln_g, w_out, norm2_g, w_gate, w_up, w_down, rel_bias, final_g):
    B, S, _ = x.shape
    for l in range(DEPTH):
        lam_init = 0.8 - 0.6 * math.exp(-0.3 * l)
        h = rmsnorm(x, norm1_g[l])
        proj = h @ w_in[l]
        u_f = proj[..., :FOURIER_WIDTH]
        q = proj[..., FOURIER_WIDTH:FOURIER_WIDTH + ATTN_WIDTH].reshape(B, S, N_HEADS, 2, HALF_DIM)
        k = proj[..., FOURIER_WIDTH + ATTN_WIDTH:FOURIER_WIDTH + 2 * ATTN_WIDTH].reshape(B, S, N_HEADS, 2, HALF_DIM)
        v = proj[..., FOURIER_WIDTH + 2 * ATTN_WIDTH:].reshape(B, S, N_HEADS, ATTN_HEAD)
        lam = (jnp.exp(jnp.sum(lambda_q1[l].astype(jnp.float32) * lambda_k1[l].astype(jnp.float32)))
               - jnp.exp(jnp.sum(lambda_q2[l].astype(jnp.float32) * lambda_k2[l].astype(jnp.float32)))
               + lam_init)
        y_f = fourier_mix(u_f, w_fourier[l])
        y_a = diff_attention(q, k, v, lam, lam_init, subln_g[l], rel_bias)
        x = x + jnp.concatenate([y_f, y_a], axis=-1) @ w_out[l]
        h2 = rmsnorm(x, norm2_g[l])
        x = x + (jax.nn.silu(h2 @ w_gate[l]) * (h2 @ w_up[l])) @ w_down[l]
    return rmsnorm(x, final_g)


def setup_inputs(seed: int = 0) -> dict:
    key = jax.random.key(seed)
    ks = jax.random.split(key, 20)
    f32 = jnp.float32
    nrm = lambda k, shape, s: (jax.random.normal(k, shape, f32) * s).astype(f32)
    return {
        "x_prompt": nrm(ks[0], (BATCH, SEQ, D_MODEL), 1.0),
        "x_sample": nrm(ks[1], (DEC_BATCH, DEC_SEQ, D_MODEL), 1.0),
        "norm1_g": 1.0 + nrm(ks[2], (DEPTH, D_MODEL), 0.02),
        "w_in": nrm(ks[3], (DEPTH, D_MODEL, IN_WIDTH), D_MODEL ** -0.5),
        "w_fourier": nrm(ks[4], (DEPTH, N_FGROUPS, FOURIER_GROUP, FOURIER_GROUP), FOURIER_GROUP ** -0.5),
        "lambda_q1": nrm(ks[5], (DEPTH, HALF_DIM), 0.1),
        "lambda_k1": nrm(ks[6], (DEPTH, HALF_DIM), 0.1),
        "lambda_q2": nrm(ks[7], (DEPTH, HALF_DIM), 0.1),
        "lambda_k2": nrm(ks[8], (DEPTH, HALF_DIM), 0.1),
        "subln_g": 1.0 + nrm(ks[9], (DEPTH, ATTN_HEAD), 0.02),
        "w_out": nrm(ks[10], (DEPTH, MIX_WIDTH, D_MODEL), MIX_WIDTH ** -0.5),
        "norm2_g": 1.0 + nrm(ks[11], (DEPTH, D_MODEL), 0.02),
        "w_gate": nrm(ks[12], (DEPTH, D_MODEL, D_FF), D_MODEL ** -0.5),
        "w_up": nrm(ks[13], (DEPTH, D_MODEL, D_FF), D_MODEL ** -0.5),
        "w_down": nrm(ks[14], (DEPTH, D_FF, D_MODEL), D_FF ** -0.5),
        "rel_bias": nrm(ks[15], (NUM_BUCKETS, N_HEADS), 0.5),
        "final_g": 1.0 + nrm(ks[16], (D_MODEL,), 0.02),
    }


def reference(x_prompt, x_sample, norm1_g, w_in, w_fourier, lambda_q1, lambda_k1, lambda_q2,
              lambda_k2, subln_g, w_out, norm2_g, w_gate, w_up, w_down, rel_bias, final_g):
    y_prompt = encoder(x_prompt, norm1_g, w_in, w_fourier, lambda_q1, lambda_k1, lambda_q2,
                       lambda_k2, subln_g, w_out, norm2_g, w_gate, w_up, w_down, rel_bias, final_g)
    y_sample = encoder(x_sample, norm1_g, w_in, w_fourier, lambda_q1, lambda_k1, lambda_q2,
                       lambda_k2, subln_g, w_out, norm2_g, w_gate, w_up, w_down, rel_bias, final_g)
    return (y_prompt, y_sample)
```

```cpp
#include <hip/hip_runtime.h>
#include <hip/hip_cooperative_groups.h>
#include <cstdio>
#include <cstdint>
namespace cg = cooperative_groups;

#ifndef ONE_LAUNCH
#define ONE_LAUNCH 1
#endif

typedef unsigned short bf16_t;
typedef short bf16x8 __attribute__((ext_vector_type(8)));
typedef short s16x4 __attribute__((ext_vector_type(4)));
typedef float f32x4 __attribute__((ext_vector_type(4)));
typedef float f32x8 __attribute__((ext_vector_type(8)));
typedef float f32x16 __attribute__((ext_vector_type(16)));
typedef unsigned u32x4 __attribute__((ext_vector_type(4)));
typedef unsigned u32x2 __attribute__((ext_vector_type(2)));
#define LAS __attribute__((address_space(3)))

constexpr int DM = 2048, NTOK = 65536, TOKP = 32768, SP = 2048, BP = 16, SS = 16384, BS = 2;
constexpr int PW = 5120;
constexpr int DFF = 5632;
constexpr float EPS = 1e-6f, LOG2E = 1.4426950408889634f;
constexpr size_t MiB = 1024 * 1024;
constexpr size_t WS_WIN = 0, WS_WOUT = 20 * MiB, WS_WGU = 28 * MiB, WS_WD = 72 * MiB, WS_SMALL = 94 * MiB;
constexpr size_t WS_AB = WS_SMALL, WS_RS1 = WS_SMALL + 1 * MiB, WS_SS = WS_RS1 + 256 * 1024  , WS_CONST = WS_SS + 512 * 1024, WS_TAB = WS_CONST + 4096, WS_BAR = WS_TAB + 16384  , WS_QCTR = WS_BAR + 3456 * 4  ;
constexpr size_t WS_PROJ = 100 * MiB, WS_MIX = 740 * MiB, WS_END = 996 * MiB;
constexpr size_t WS_X1B = WS_PROJ, WS_ACT = WS_PROJ + 256 * MiB;
constexpr size_t OUT_XB = 0, OUT_STASH = 0, OUT_T = 256 * MiB;
constexpr int LDS_BYTES = 140 * 1024;

struct Params {
  const float *xp, *xs, *g1, *w_in, *w_f, *lq1, *lk1, *lq2, *lk2, *subg, *w_out, *g2, *w_gate, *w_up, *w_down, *relb, *fg;
  float* out; unsigned char* ws; int ph_lo, ph_hi;
};

__device__ __forceinline__ int otid() { int t = threadIdx.x; asm volatile("" : "+v"(t)); return t; }
__device__ __forceinline__ int obid() { int t = blockIdx.x; asm volatile("" : "+v"(t)); return __builtin_amdgcn_readfirstlane(t); }
__device__ __forceinline__ int ogrid() { int t = gridDim.x; asm volatile("" : "+v"(t)); return __builtin_amdgcn_readfirstlane(t); }
__device__ __forceinline__ unsigned cvt_pk_bf16(float lo, float hi) { unsigned r; asm volatile("v_cvt_pk_bf16_f32 %0, %1, %2" : "=v"(r) : "v"(lo), "v"(hi)); return r; }
__device__ __forceinline__ bf16_t f2bf(float x) { return (bf16_t)(cvt_pk_bf16(x, 0.f) & 0xffffu); }

namespace pg8 {
constexpr int BM = 256, BK = 64, HALF = 128, HTB = HALF * BK * 2, STAGE_BYTES = 8 * HTB, NXCD = 8, WGM = 8;
__device__ __forceinline__ int lds_byte(int r, int c) { const int st = (r >> 4) * 2 + (c >> 5), rr = r & 15, cc = c & 31, ob = rr * 64 + cc * 2; return st * 1024 + (ob ^ (((ob >> 9) & 1) << 5)); }
__device__ __forceinline__ void stage_rc(int b, int& R, int& C) { const int st = b / 1024, sb = b % 1024, swz = sb ^ (((sb >> 9) & 1) << 5); R = (st >> 1) * 16 + swz / 64; C = (st & 1) * 32 + (swz % 64) / 2; }
__device__ __forceinline__ int perm32(int rho) { const int n = rho >> 4, i = rho & 15; return 8 * (i >> 2) + 4 * n + (i & 3); }
struct Unit { int pm, pn; };
struct Gemm { const bf16_t* A; const bf16_t* Bt; int M, N, K; };
struct StaticOrder {
  int nM, nN, nwg, G, c;
  __device__ void init(int M, int N, int G_, int c_) { nM = M / BM; nN = N / BM; nwg = nM * nN; G = G_; c = c_; }
  __device__ bool next(int i, Unit& u) const {
    const long L = (long)i * G + c; if (L >= nwg) return false;
    int wgid = (int)L; { const int q = nwg / NXCD, r = nwg % NXCD, xcd = wgid % NXCD, off = wgid / NXCD; wgid = (xcd < r ? xcd * (q + 1) : r * (q + 1) + (xcd - r) * q) + off; }
    const int nig = WGM * nN, gid = wgid / nig, fm = gid * WGM, gsz = (nM - fm) < WGM ? (nM - fm) : WGM;
    u.pm = fm + ((wgid % nig) % gsz); u.pn = (wgid % nig) / gsz; return true;
  }
};
template <class Epi>
__device__ __forceinline__ void gemm_phase(LAS unsigned char* lds, const Gemm g, const StaticOrder& S, const Epi& E) {
  const int tid = otid(), wid = __builtin_amdgcn_readfirstlane(tid >> 6), lane = tid & 63, wr = wid >> 2, wc = wid & 3, fr = lane & 15, fq = lane >> 4;
  const int K = g.K, nt = K / BK;
  unsigned voffA[2], voffB[2];
#pragma unroll
  for (int i = 0; i < 2; ++i) { int R, C; stage_rc(tid * 16 + i * 8192, R, C); const int Rb = Epi::PERM ? ((R & ~31) + perm32(R & 31)) : R;
    voffA[i] = (unsigned)(R * K + C) * 2u; voffB[i] = (unsigned)(Rb * K + C) * 2u; }
  const size_t kstep = (size_t)(BK * 2);
  const size_t hstep = (size_t)HALF * K * 2;
  const size_t tstep = 2 * hstep;
  const unsigned ldsw = (unsigned)wid * 1024u;
  const int aoff = lds_byte(wr * 64 + fr, fq * 8), boff = lds_byte(wc * 32 + fr, fq * 8);
#define PG8_SA(b, h) (((b) * 2 + (h)) * HTB)
#define PG8_SB(b, h) ((4 + (b) * 2 + (h)) * HTB)
#define PG8_STAGE(bufoff, gbase, voff) do { _Pragma("unroll") for (int _i = 0; _i < 2; ++_i) \
    __builtin_amdgcn_global_load_lds((const unsigned*)((const char*)(gbase) + (voff)[_i]), (LAS unsigned*)(lds + (bufoff) + ldsw + _i * 8192), 16, 0, 0); } while (0)
#define PG8_LDA(dst, b, h) do { _Pragma("unroll") for (int m = 0; m < 4; ++m) _Pragma("unroll") for (int k = 0; k < 2; ++k) dst[m][k] = *(const LAS bf16x8*)(lds + PG8_SA(b, h) + aoff + m * 2048 + k * 1024); } while (0)
#define PG8_LDB(dst, b, h) do { _Pragma("unroll") for (int n = 0; n < 2; ++n) _Pragma("unroll") for (int k = 0; k < 2; ++k) dst[n][k] = *(const LAS bf16x8*)(lds + PG8_SB(b, h) + boff + n * 2048 + k * 1024); } while (0)
#define PG8_MMA(ai, bj, At, Bt) do { __builtin_amdgcn_s_setprio(1); _Pragma("unroll") for (int m = 0; m < 4; ++m) _Pragma("unroll") for (int n = 0; n < 2; ++n) _Pragma("unroll") for (int k = 0; k < 2; ++k) \
    acc[ai][bj][m][n] = __builtin_amdgcn_mfma_f32_16x16x32_bf16(Bt[n][k], At[m][k], acc[ai][bj][m][n], 0, 0, 0); __builtin_amdgcn_s_setprio(0); } while (0)
#define PG8_WAIT_V(n) asm volatile("s_waitcnt vmcnt(" #n ")" ::: "memory")
#define PG8_WAIT_L(n) asm volatile("s_waitcnt lgkmcnt(" #n ")" ::: "memory")
#define PG8_BAR __builtin_amdgcn_s_barrier()
#define PG8_SCHED __builtin_amdgcn_sched_barrier(0)
  Unit cur, nxt; int ui = 0;
  if (!S.next(0, cur)) return;
  f32x4 acc[2][2][4][2];
#pragma unroll
  for (int a = 0; a < 2; ++a)
#pragma unroll
    for (int b = 0; b < 2; ++b)
#pragma unroll
      for (int m = 0; m < 4; ++m)
#pragma unroll
        for (int n = 0; n < 2; ++n) acc[a][b][m][n] = (f32x4){0.f, 0.f, 0.f, 0.f};
  bf16x8 At[4][2], B0[2][2], B1[2][2];
  const char* cA = (const char*)g.A + (size_t)cur.pm * tstep; const char* cB = (const char*)g.Bt + (size_t)cur.pn * tstep;
  PG8_STAGE(PG8_SB(0, 0), cB, voffB); PG8_STAGE(PG8_SB(0, 1), cB + hstep, voffB); PG8_STAGE(PG8_SA(0, 0), cA, voffA); PG8_STAGE(PG8_SA(0, 1), cA + hstep, voffA);
  if (wr == 1) PG8_BAR;
  PG8_WAIT_V(2); PG8_BAR;
  PG8_STAGE(PG8_SB(1, 0), cB + kstep, voffB); PG8_STAGE(PG8_SA(1, 0), cA + kstep, voffA); PG8_STAGE(PG8_SB(1, 1), cB + hstep + kstep, voffB);
  PG8_WAIT_V(6); PG8_BAR;
  for (;;) {
    const bool has_next = S.next(ui + 1, nxt);
    const char* nA = has_next ? (const char*)g.A + (size_t)nxt.pm * tstep : cA; const char* nB = has_next ? (const char*)g.Bt + (size_t)nxt.pn * tstep : cB;
    for (int t = 0; t < nt; t += 2) {
      const bool last = (t == nt - 2);
      const char* a1 = cA + (size_t)(t + 1) * kstep;
      const char* a2 = last ? nA : cA + (size_t)(t + 2) * kstep; const char* b2 = last ? nB : cB + (size_t)(t + 2) * kstep;
      const char* a3 = a2 + kstep; const char* b3 = b2 + kstep;
      PG8_LDB(B0, 0, 0); PG8_LDB(B1, 0, 1); PG8_SCHED; PG8_LDA(At, 0, 0); PG8_STAGE(PG8_SA(1, 1), a1 + hstep, voffA);
      PG8_WAIT_V(8); PG8_WAIT_L(0); PG8_BAR; PG8_MMA(0, 0, At, B0); PG8_MMA(0, 1, At, B1); PG8_BAR; PG8_SCHED;
      PG8_LDA(At, 0, 1); PG8_STAGE(PG8_SB(0, 0), b2, voffB); PG8_STAGE(PG8_SB(0, 1), b2 + hstep, voffB); PG8_STAGE(PG8_SA(0, 0), a2, voffA);
      PG8_WAIT_V(8); PG8_WAIT_L(0); PG8_BAR; PG8_MMA(1, 0, At, B0); PG8_MMA(1, 1, At, B1); PG8_BAR; PG8_SCHED;
      PG8_LDB(B0, 1, 0); PG8_LDB(B1, 1, 1); PG8_SCHED; PG8_LDA(At, 1, 0); PG8_STAGE(PG8_SA(0, 1), a2 + hstep, voffA);
      PG8_WAIT_V(8); PG8_WAIT_L(0); PG8_BAR; PG8_MMA(0, 0, At, B0); PG8_MMA(0, 1, At, B1); PG8_BAR; PG8_SCHED;
      PG8_LDA(At, 1, 1); PG8_STAGE(PG8_SB(1, 0), b3, voffB); PG8_STAGE(PG8_SB(1, 1), b3 + hstep, voffB); PG8_STAGE(PG8_SA(1, 0), a3, voffA);
      PG8_WAIT_V(8); PG8_WAIT_L(0); PG8_BAR; PG8_MMA(1, 0, At, B0); PG8_MMA(1, 1, At, B1); PG8_BAR; PG8_SCHED;
    }
    if (wr == 0) PG8_BAR;
    E(acc, cur, wr, wc, fr, fq);
    if (!has_next) break;
#pragma unroll
    for (int a = 0; a < 2; ++a)
#pragma unroll
      for (int b = 0; b < 2; ++b)
#pragma unroll
        for (int m = 0; m < 4; ++m)
#pragma unroll
          for (int n = 0; n < 2; ++n) acc[a][b][m][n] = (f32x4){0.f, 0.f, 0.f, 0.f};
    cur = nxt; cA = nA; cB = nB; ++ui;
    if (wr == 1) PG8_BAR;
  }
  PG8_WAIT_V(0);
  PG8_BAR;
#undef PG8_SA
#undef PG8_SB
#undef PG8_STAGE
#undef PG8_LDA
#undef PG8_LDB
#undef PG8_MMA
#undef PG8_WAIT_V
#undef PG8_WAIT_L
#undef PG8_BAR
#undef PG8_SCHED
}
}

struct EpiProj {
  static constexpr bool PERM = true;
  bf16_t* O; const float* rs;
  __device__ __forceinline__ void operator()(const f32x4 (&acc)[2][2][4][2], const pg8::Unit& u, int wr, int wc, int fr, int fq) const {
    const int row0 = u.pm * 256 + wr * 64 + fr, col0 = u.pn * 256 + wc * 32 + 8 * fq;
#pragma unroll
    for (int ai = 0; ai < 2; ++ai)
#pragma unroll
      for (int m = 0; m < 4; ++m) { const int row = row0 + ai * 128 + m * 16; const float s = rs[row]; bf16_t* rowp = O + (size_t)row * PW + col0;
#pragma unroll
        for (int bj = 0; bj < 2; ++bj) { const f32x4 v0 = acc[ai][bj][m][0] * s, v1 = acc[ai][bj][m][1] * s;
          u32x4 w; w.x = cvt_pk_bf16(v0[0], v0[1]); w.y = cvt_pk_bf16(v0[2], v0[3]); w.z = cvt_pk_bf16(v1[0], v1[1]); w.w = cvt_pk_bf16(v1[2], v1[3]);
          *(u32x4*)(rowp + bj * 128) = w; } }
  }
};
struct EpiOut {
  static constexpr bool PERM = false;
  const float* xp; const float* xs; float* x1; bf16_t* x1b; float* ss;
  __device__ __forceinline__ void operator()(const f32x4 (&acc)[2][2][4][2], const pg8::Unit& u, int wr, int wc, int fr, int fq) const {
    const int row0 = u.pm * 256 + wr * 64 + fr, col0 = u.pn * 256 + wc * 32 + 4 * fq;
#pragma unroll
    for (int ai = 0; ai < 2; ++ai)
#pragma unroll
      for (int m = 0; m < 4; ++m) { const int row = row0 + ai * 128 + m * 16;
        const float* xr = (row < TOKP ? xp + (size_t)row * DM : xs + (size_t)(row - TOKP) * DM) + col0;
        bf16_t* ob = x1b + (size_t)row * DM + col0; float sq = 0.f;
#pragma unroll
        for (int bj = 0; bj < 2; ++bj)
#pragma unroll
          for (int n = 0; n < 2; ++n) { const int c = bj * 128 + n * 16; const f32x4 v = acc[ai][bj][m][n] + *(const f32x4*)(xr + c);
            u32x2 w; w.x = cvt_pk_bf16(v[0], v[1]); w.y = cvt_pk_bf16(v[2], v[3]); *(u32x2*)(ob + c) = w;
            sq += v[0] * v[0] + v[1] * v[1] + v[2] * v[2] + v[3] * v[3]; }
        sq += __shfl_xor(sq, 16); sq += __shfl_xor(sq, 32);
        if (fq == 0) atomicAdd(ss + row, sq); }
  }
};
struct EpiFfn1 {
  static constexpr bool PERM = true;
  bf16_t* act; const float* ss2; int rowbase;
  __device__ __forceinline__ void operator()(const f32x4 (&acc)[2][2][4][2], const pg8::Unit& u, int wr, int wc, int fr, int fq) const {
    const int row0 = u.pm * 256 + wr * 64 + fr, col0 = u.pn * 128 + wc * 32 + 8 * fq;
#pragma unroll
    for (int ai = 0; ai < 2; ++ai)
#pragma unroll
      for (int m = 0; m < 4; ++m) { const int row = row0 + ai * 128 + m * 16; const float s = rsqrtf(ss2[rowbase + row] * (1.f / DM) + EPS);
        float a[8];
#pragma unroll
        for (int n = 0; n < 2; ++n)
#pragma unroll
          for (int j = 0; j < 4; ++j) { const float gg = acc[ai][0][m][n][j] * s, uu = acc[ai][1][m][n][j] * s;
            a[n * 4 + j] = gg * __builtin_amdgcn_rcpf(1.f + __expf(-gg)) * uu; }
        u32x4 w; w.x = cvt_pk_bf16(a[0], a[1]); w.y = cvt_pk_bf16(a[2], a[3]); w.z = cvt_pk_bf16(a[4], a[5]); w.w = cvt_pk_bf16(a[6], a[7]);
        *(u32x4*)(act + (size_t)row * DFF + col0) = w; }
  }
};
struct EpiFfn2 {
  static constexpr bool PERM = false;
  bf16_t* xb; float* ss; int rowbase;
  __device__ __forceinline__ void operator()(const f32x4 (&acc)[2][2][4][2], const pg8::Unit& u, int wr, int wc, int fr, int fq) const {
    const int row0 = rowbase + u.pm * 256 + wr * 64 + fr, col0 = u.pn * 256 + wc * 32 + 4 * fq;
#pragma unroll
    for (int ai = 0; ai < 2; ++ai)
#pragma unroll
      for (int m = 0; m < 4; ++m) { const int row = row0 + ai * 128 + m * 16; bf16_t* br = xb + (size_t)row * DM + col0; float sq = 0.f;
#pragma unroll
        for (int bj = 0; bj < 2; ++bj)
#pragma unroll
          for (int n = 0; n < 2; ++n) { const int c = bj * 128 + n * 16; const u32x2 w = *(const u32x2*)(br + c);
            const f32x4 r = {__uint_as_float(w.x << 16), __uint_as_float(w.x & 0xffff0000u), __uint_as_float(w.y << 16), __uint_as_float(w.y & 0xffff0000u)};
            const f32x4 v = acc[ai][bj][m][n] + r;
            u32x2 o; o.x = cvt_pk_bf16(v[0], v[1]); o.y = cvt_pk_bf16(v[2], v[3]); *(u32x2*)(br + c) = o;
            sq += v[0] * v[0] + v[1] * v[1] + v[2] * v[2] + v[3] * v[3]; }
        sq += __shfl_xor(sq, 16); sq += __shfl_xor(sq, 32);
        if (fq == 0) atomicAdd(ss + row, sq); }
  }
};

__device__ __forceinline__ void tconv_tile(const float* src, int ldsrc, const float* sk, float cs, bf16_t* dst, int ldd, int mode, int k0, int n0, float* tile) {
  const int tid = otid();
  __syncthreads();
  { const int nl = tid & 63, kl = tid >> 6;
#pragma unroll
    for (int p = 0; p < 8; ++p) tile[(kl + 8 * p) * 65 + nl] = src[(size_t)(k0 + kl + 8 * p) * ldsrc + n0 + nl]; }
  __syncthreads();
  { const int kl = tid & 63, nl = tid >> 6; const float s = (sk ? sk[k0 + kl] : 1.f) * cs;
#pragma unroll
    for (int p = 0; p < 8; ++p) { const int n = n0 + nl + 8 * p; int row = n;
      if (mode == 1) row = (n >> 7) * 256 + (n & 127); else if (mode == 2) row = (n >> 7) * 256 + 128 + (n & 127);
      dst[(size_t)row * ldd + k0 + kl] = f2bf(tile[kl * 65 + nl + 8 * p] * s); } }
}

__device__ void phase_prep(const Params& p, unsigned char* shm) {
  const int tid = otid(), G = ogrid(), bid = obid(), wid = tid >> 6, lane = tid & 63;
  float* ss = (float*)(p.ws + WS_SS);
  for (int i = bid * 512 + tid; i < 2 * NTOK; i += G * 512) ss[i] = 0.f;
  if (bid == 0) {
    float* consts = (float*)(p.ws + WS_CONST); float* tab = (float*)(p.ws + WS_TAB);
    if (tid == 0) { float a = 0.f, b = 0.f; for (int i = 0; i < 64; ++i) { a += p.lq1[i] * p.lk1[i]; b += p.lq2[i] * p.lk2[i]; } consts[0] = expf(a) - expf(b) + 0.2f; }
    for (int i = tid; i < 8 * 257; i += 512) { const int h = i / 257, j = i % 257, rel = j - 128, n = rel < 0 ? -rel : rel;
      int bk = n < 8 ? n : 8 + (n >= 12) + (n >= 16) + (n >= 23) + (n >= 32) + (n >= 46) + (n >= 64) + (n >= 91);
      if (rel > 0) bk += 16;
      tab[i] = p.relb[bk * 8 + h] * LOG2E; }
  }
  float* ct = (float*)shm;
  if (tid < 128) ct[tid] = cospif((float)tid * (1.f / 64.f));
  __syncthreads();
  float* AB = (float*)(p.ws + WS_AB);
  for (int i = bid * 512 + tid; i < 8 * 2 * 128 * 128; i += G * 512) {
    const int e = i & 127, c = (i >> 7) & 127, part = (i >> 14) & 1, g = i >> 15; float acc = 0.f;
    for (int m = 0; m < 128; ++m) { const int j = (c * m - part * 32) & 127; acc += ct[j] * p.w_f[(size_t)(g * 128 + m) * 128 + e]; }
    AB[i] = acc * 0.08838834764831845f;
  }
  __syncthreads();
  float* tile = (float*)shm;
  bf16_t* Win = (bf16_t*)(p.ws + WS_WIN); bf16_t* Wout = (bf16_t*)(p.ws + WS_WOUT); bf16_t* Wgu = (bf16_t*)(p.ws + WS_WGU); bf16_t* Wd = (bf16_t*)(p.ws + WS_WD);
  for (int t = bid; t < 11008; t += G) {
    if (t < 512)        { const int u = t;        tconv_tile(p.w_in + 1024, 4096, p.g1, 0.125f * LOG2E, Win + (size_t)2048 * DM, DM, 0, (u / 16) * 64, (u % 16) * 64, tile); }
    else if (t < 1536)  { const int u = t - 512;  tconv_tile(p.w_in + 2048, 4096, p.g1, 1.f, Win + (size_t)3072 * DM, DM, 0, (u / 32) * 64, (u % 32) * 64, tile); }
    else if (t < 2560)  { const int u = t - 1536; tconv_tile(p.w_out, 2048, nullptr, 1.f, Wout, DM, 0, (u / 32) * 64, (u % 32) * 64, tile); }
    else if (t < 5376)  { const int u = t - 2560; tconv_tile(p.w_gate, DFF, p.g2, 1.f, Wgu, DM, 1, (u / 88) * 64, (u % 88) * 64, tile); }
    else if (t < 8192)  { const int u = t - 5376; tconv_tile(p.w_up, DFF, p.g2, 1.f, Wgu, DM, 2, (u / 88) * 64, (u % 88) * 64, tile); }
    else                { const int u = t - 8192; tconv_tile(p.w_down, DM, nullptr, 1.f, Wd, DFF, 0, (u / 32) * 64, (u % 32) * 64, tile); }
  }
  bf16_t* xb = (bf16_t*)((unsigned char*)p.out + OUT_XB); float* rs1 = (float*)(p.ws + WS_RS1);
  for (int row = bid * 8 + wid; row < NTOK; row += G * 8) {
    const float* xr = row < TOKP ? p.xp + (size_t)row * DM : p.xs + (size_t)(row - TOKP) * DM; float sq = 0.f;
#pragma unroll
    for (int it = 0; it < 4; ++it) { const int c = it * 512 + lane * 8; const f32x4 a = *(const f32x4*)(xr + c), b = *(const f32x4*)(xr + c + 4);
      sq += a[0] * a[0] + a[1] * a[1] + a[2] * a[2] + a[3] * a[3] + b[0] * b[0] + b[1] * b[1] + b[2] * b[2] + b[3] * b[3];
      u32x4 w; w.x = cvt_pk_bf16(a[0], a[1]); w.y = cvt_pk_bf16(a[2], a[3]); w.z = cvt_pk_bf16(b[0], b[1]); w.w = cvt_pk_bf16(b[2], b[3]);
      *(u32x4*)(xb + (size_t)row * DM + c) = w; }
#pragma unroll
    for (int o = 32; o >= 1; o >>= 1) sq += __shfl_xor(sq, o);
    if (lane == 0) rs1[row] = rsqrtf(sq * (1.f / DM) + EPS);
  }
}

__device__ void phase_fold(const Params& p, unsigned char* shm) {
  const int tid = otid(), G = ogrid(), bid = obid();
  float* wt = (float*)shm;
  float* ab = (float*)(shm + 33280);
  const float* AB = (const float*)(p.ws + WS_AB); bf16_t* Win = (bf16_t*)(p.ws + WS_WIN);
  for (int it = bid; it < 512; it += G) {
    const int kb = it & 31, part = (it >> 5) & 1, g = it >> 6, k0 = kb * 64;
    __syncthreads();
    for (int i = tid; i < 64 * 128; i += 512) { const int kl = i >> 7, c = i & 127; wt[kl * 129 + c] = p.w_in[(size_t)(k0 + kl) * 4096 + g * 128 + c]; }
    for (int i = tid; i < 128 * 128; i += 512) ab[i] = AB[(size_t)((g * 2 + part) * 128) * 128 + i];
    __syncthreads();
    const int kl = tid & 63, eg = tid >> 6; float acc[16];
#pragma unroll
    for (int i = 0; i < 16; ++i) acc[i] = 0.f;
    for (int c = 0; c < 128; ++c) { const float w = wt[kl * 129 + c]; const float* ar = ab + c * 128 + eg * 16;
#pragma unroll
      for (int q = 0; q < 4; ++q) { const f32x4 a = *(const f32x4*)(ar + q * 4); acc[q * 4 + 0] += w * a[0]; acc[q * 4 + 1] += w * a[1]; acc[q * 4 + 2] += w * a[2]; acc[q * 4 + 3] += w * a[3]; } }
    const float s = p.g1[k0 + kl];
#pragma unroll
    for (int i = 0; i < 16; ++i) Win[(size_t)(part * 1024 + g * 128 + eg * 16 + i) * DM + k0 + kl] = f2bf(acc[i] * s);
  }
}

template <int KK, int NT> struct BTile {
  static constexpr int RS = NT * 2 + 16, CPR = NT / 8, RPP = 512 / CPR, NP = KK / RPP;
  bf16x8 v[NP];
  template <class RowPtr> __device__ __forceinline__ void gload(int tid, RowPtr rp) {
    const int c = tid % CPR, r0 = tid / CPR;
#pragma unroll
    for (int q = 0; q < NP; ++q) v[q] = *(const bf16x8*)(rp(r0 + q * RPP) + c * 8);
  }
  __device__ __forceinline__ void lstore(int tid, unsigned char* tile) const {
    const int c = tid % CPR, r0 = tid / CPR;
#pragma unroll
    for (int q = 0; q < NP; ++q) *(bf16x8*)(tile + (r0 + q * RPP) * RS + c * 16) = v[q];
  }
  static __device__ __forceinline__ int rd_base(unsigned char* tile, int lane) { const int g = lane >> 4, q = (lane & 15) >> 2, pp = lane & 3; return (int)(uintptr_t)tile + (8 * g + q) * RS + 8 * pp; }
};
template <int OFF> __device__ __forceinline__ s16x4 tr_rd(int vb) {
  s16x4 r; asm volatile("ds_read_b64_tr_b16 %0, %1 offset:%2" : "=&v"(r) : "v"(vb), "i"(OFF) : "memory"); return r;
}
#define TRFRAG(DST, vb, OFF, RS_) do { const int _a = (vb) + (OFF); const s16x4 _l = tr_rd<0>(_a), _h = tr_rd<4 * (RS_)>(_a); asm volatile("s_waitcnt lgkmcnt(0)" ::: "memory"); \
    DST = (bf16x8){_l[0], _l[1], _l[2], _l[3], _h[0], _h[1], _h[2], _h[3]}; } while (0)

template <int NB> struct S1Loop;
__device__ void fourier_stage1(const bf16_t* proj, bf16_t* Tb, unsigned char* shm) {
  constexpr int KK = 256, NT = 128;
  using BT = BTile<KK, NT>; constexpr int RS = BT::RS;
  const int tid = otid(), wid = tid >> 6, lane = tid & 63, fr = lane & 15, fq = lane >> 4, G = ogrid(), bid = obid();
  const int k1 = wid * 16 + fr;
  bf16x8 ar[8], ai[8];
#pragma unroll
  for (int ks = 0; ks < 8; ++ks)
#pragma unroll
    for (int e = 0; e < 8; e += 2) { float vr[2], vi[2];
#pragma unroll
      for (int d = 0; d < 2; ++d) { const int kk = ks * 32 + fq * 8 + e + d, pin = kk >> 7, s1 = kk & 127, j = (s1 * k1) & 127;
        const float cc = cospif((float)j * (1.f / 64.f)), sn = sinpif((float)j * (1.f / 64.f));
        vr[d] = pin ? -sn : cc; vi[d] = pin ? -cc : -sn; }
      const unsigned wr_ = cvt_pk_bf16(vr[0], vr[1]), wi_ = cvt_pk_bf16(vi[0], vi[1]);
      ar[ks][e] = (short)(wr_ & 0xffff); ar[ks][e + 1] = (short)(wr_ >> 16); ai[ks][e] = (short)(wi_ & 0xffff); ai[ks][e + 1] = (short)(wi_ >> 16); }
  const int vb = BT::rd_base(shm, lane);
  BT bt;
#define S1_DECODE(it) int tb, N2, S, s2, ct; if ((it) < 2048) { const int b = (it) >> 10; s2 = ((it) >> 3) & 127; ct = (it) & 7; tb = TOKP + b * SS; N2 = 128; S = SS; } \
    else { const int u = (it) - 2048, b = u >> 7; s2 = (u >> 3) & 15; ct = u & 7; tb = b * SP; N2 = 16; S = SP; } const int col0 = ct * NT; (void)S;
  if (bid < 4096) { S1_DECODE(bid); bt.gload(tid, [&](int r) { const int pin = r >> 7, s1 = r & 127; return proj + (size_t)(tb + N2 * s1 + s2) * PW + pin * 1024 + col0; }); }
  for (int it = bid; it < 4096; it += G) {
    S1_DECODE(it);
    __syncthreads();
    bt.lstore(tid, shm);
    __syncthreads();
    if (it + G < 4096) { const int itn = it + G; int tbn, N2n, s2n, ctn;
      if (itn < 2048) { const int b = itn >> 10; s2n = (itn >> 3) & 127; ctn = itn & 7; tbn = TOKP + b * SS; N2n = 128; }
      else { const int u = itn - 2048, b = u >> 7; s2n = (u >> 3) & 15; ctn = u & 7; tbn = b * SP; N2n = 16; }
      bt.gload(tid, [&](int r) { const int pin = r >> 7, s1 = r & 127; return proj + (size_t)(tbn + N2n * s1 + s2n) * PW + pin * 1024 + ctn * NT; }); }
    int vbi = vb; asm volatile("" : "+v"(vbi));
    const int jj = (s2 * k1) & (S - 1); const float ang = (float)jj * (2.f / (float)S); const float cw = cospif(ang), sw = sinpif(ang), sc = 0.08838834764831845f;
    unsigned char* stg = shm + 69632 + wid * 8704;
#pragma unroll
    for (int nb = 0; nb < NT / 16; ++nb) {
      f32x4 tr = {0.f, 0.f, 0.f, 0.f}, ti = {0.f, 0.f, 0.f, 0.f};
      s16x4 fl[8], fh[8];
#pragma unroll
      for (int ks = 0; ks < 8; ++ks) { const int a_ = vbi + ks * 32 * RS + nb * 32; fl[ks] = tr_rd<0>(a_); fh[ks] = tr_rd<4 * RS>(a_); }
      asm volatile("s_waitcnt lgkmcnt(0)" ::: "memory"); __builtin_amdgcn_sched_barrier(0);
#pragma unroll
      for (int ks = 0; ks < 8; ++ks) { const bf16x8 b = (bf16x8){fl[ks][0], fl[ks][1], fl[ks][2], fl[ks][3], fh[ks][0], fh[ks][1], fh[ks][2], fh[ks][3]};
        tr = __builtin_amdgcn_mfma_f32_16x16x32_bf16(b, ar[ks], tr, 0, 0, 0); ti = __builtin_amdgcn_mfma_f32_16x16x32_bf16(b, ai[ks], ti, 0, 0, 0); }
      float xr[4], xi[4];
#pragma unroll
      for (int j = 0; j < 4; ++j) { xr[j] = (tr[j] * cw + ti[j] * sw) * sc; xi[j] = (ti[j] * cw - tr[j] * sw) * sc; }
      u32x2 w0, w1; w0.x = cvt_pk_bf16(xr[0], xr[1]); w0.y = cvt_pk_bf16(xr[2], xr[3]); w1.x = cvt_pk_bf16(xi[0], xi[1]); w1.y = cvt_pk_bf16(xi[2], xi[3]);
      *(u32x2*)(stg + fr * 272 + (nb * 16 + fq * 4) * 2) = w0; *(u32x2*)(stg + 4352 + fr * 272 + (nb * 16 + fq * 4) * 2) = w1;
    }
    { bf16_t* ob = Tb + (size_t)tb * 2048 + (size_t)s2 * 128 * 1024 + (size_t)(wid * 16) * 1024 + col0;
#pragma unroll
      for (int q = 0; q < 8; ++q) { const int idx = q * 64 + lane, part = idx >> 8, row = (idx >> 4) & 15, ch = idx & 15;
        const u32x4 v = *(const u32x4*)(stg + part * 4352 + row * 272 + ch * 16);
        *(u32x4*)(ob + (size_t)part * N2 * 128 * 1024 + row * 1024 + ch * 8) = v; } }
  }
#undef S1_DECODE
}

template <int N2, int NT>
__device__ void fourier_stage2(const bf16_t* Tb, bf16_t* mix, int tb0, int nbatch, unsigned char* shm) {
  constexpr int KK = 2 * N2, KST = KK / 32, MB = N2 / 16, NWN = 8 / MB, S = 128 * N2, CT = 1024 / NT, NBW = (NT / 16) / NWN;
  using BT = BTile<KK, NT>; constexpr int RS = BT::RS;
  const int tid = otid(), wid = tid >> 6, lane = tid & 63, fr = lane & 15, fq = lane >> 4, G = ogrid(), bid = obid();
  const int mb = wid % MB, wn = wid / MB, k2 = mb * 16 + fr;
  bf16x8 af[KST];
#pragma unroll
  for (int ks = 0; ks < KST; ++ks)
#pragma unroll
    for (int e = 0; e < 8; e += 2) { float v[2];
#pragma unroll
      for (int d = 0; d < 2; ++d) { const int kk = ks * 32 + fq * 8 + e + d, part = kk / N2, s2 = kk % N2, j = (s2 * k2) % N2; const float a = (float)j * (2.f / (float)N2);
        v[d] = part ? sinpif(a) : cospif(a); }
      const unsigned w = cvt_pk_bf16(v[0], v[1]); af[ks][e] = (short)(w & 0xffff); af[ks][e + 1] = (short)(w >> 16); }
  const float sc = rsqrtf((float)N2);
  const int nitems = nbatch * 128 * CT;
  const int vb = BT::rd_base(shm, lane) + wn * NBW * 32;
  BT bt;
  auto rowp = [&](int it, int r) { const int ct = it % CT, k1 = (it / CT) & 127, b = it / (CT * 128), tb = tb0 + b * S; const int part = r / N2, s2 = r % N2;
    return Tb + (size_t)tb * 2048 + ((size_t)(part * N2 + s2) * 128 + k1) * 1024 + ct * NT; };
  if (bid < nitems) bt.gload(tid, [&](int r) { return rowp(bid, r); });
  for (int it = bid; it < nitems; it += G) {
    const int ct = it % CT, k1 = (it / CT) & 127, b = it / (CT * 128), tb = tb0 + b * S, col0 = ct * NT;
    __syncthreads();
    bt.lstore(tid, shm);
    __syncthreads();
    if (it + G < nitems) { const int itn = it + G; bt.gload(tid, [&](int r) { return rowp(itn, r); }); }
    int vbi = vb; asm volatile("" : "+v"(vbi));
    unsigned char* stg = shm + 69632 + wid * 4352;
#pragma unroll
    for (int i = 0; i < NBW; ++i) {
      f32x4 y = {0.f, 0.f, 0.f, 0.f};
      s16x4 fl[KST], fh[KST];
#pragma unroll
      for (int ks = 0; ks < KST; ++ks) { const int a_ = vbi + ks * 32 * RS + i * 32; fl[ks] = tr_rd<0>(a_); fh[ks] = tr_rd<4 * RS>(a_); }
      asm volatile("s_waitcnt lgkmcnt(0)" ::: "memory"); __builtin_amdgcn_sched_barrier(0);
#pragma unroll
      for (int ks = 0; ks < KST; ++ks) { const bf16x8 bb = (bf16x8){fl[ks][0], fl[ks][1], fl[ks][2], fl[ks][3], fh[ks][0], fh[ks][1], fh[ks][2], fh[ks][3]};
        y = __builtin_amdgcn_mfma_f32_16x16x32_bf16(bb, af[ks], y, 0, 0, 0); }
      u32x2 w; w.x = cvt_pk_bf16(y[0] * sc, y[1] * sc); w.y = cvt_pk_bf16(y[2] * sc, y[3] * sc);
      *(u32x2*)(stg + fr * 272 + (i * 16 + fq * 4) * 2) = w;
    }
    { bf16_t* ob = mix + (size_t)(tb + k1 + 128 * (mb * 16)) * DM + col0 + wn * NBW * 16;
#pragma unroll
      for (int q = 0; q < 4; ++q) { const int idx = q * 64 + lane, row = idx >> 4, ch = idx & 15;
        const u32x4 v = *(const u32x4*)(stg + row * 272 + ch * 16);
        *(u32x4*)(ob + (size_t)(128 * row) * DM + ch * 8) = v; } }
  }
}

namespace at {
constexpr int KVBLK = 64, LD = PW;
constexpr size_t SHM_V = KVBLK * 128 * 2, SHM_K = KVBLK * 128 * 2;
#define KSWZ(row, colB) ((row) * 256 + ((colB) ^ (((row) & 7) << 4)))
#define SBAR() __builtin_amdgcn_sched_barrier(0)
__device__ __forceinline__ int crow(int r, int hi) { return (r & 3) + 8 * (r >> 2) + 4 * hi; }
__device__ __forceinline__ void tileBias(f32x16& p0, f32x16& p1, const float* tabl) {
#pragma unroll
  for (int r = 0; r < 16; ++r) p0[r] += tabl[(r & 3) + 8 * (r >> 2)];
  SBAR();
#pragma unroll
  for (int r = 0; r < 16; ++r) p1[r] += tabl[32 + (r & 3) + 8 * (r >> 2)];
  SBAR();
}
__device__ __forceinline__ void expHalf(f32x16& p) {
#pragma unroll
  for (int r = 0; r < 16; ++r) p[r] = __builtin_amdgcn_exp2f(p[r]);
}
__device__ __forceinline__ void firstSM(f32x16& p0, f32x16& p1, float& M, bool nearT, float bconst, const float* tabl) {
  if (nearT) tileBias(p0, p1, tabl);
  float pmax = p0[0];
#pragma unroll
  for (int r = 1; r < 16; ++r) pmax = fmaxf(pmax, p0[r]);
#pragma unroll
  for (int r = 0; r < 16; ++r) pmax = fmaxf(pmax, p1[r]);
  { auto rr = __builtin_amdgcn_permlane32_swap(__float_as_uint(pmax), __float_as_uint(pmax), false, false);
    pmax = fmaxf(__uint_as_float(rr[0]), __uint_as_float(rr[1])); }
  M = pmax + bconst;
  const float off = bconst - M;
#pragma unroll
  for (int r = 0; r < 16; ++r) p0[r] += off;
#pragma unroll
  for (int r = 0; r < 16; ++r) p1[r] += off;
  expHalf(p0); expHalf(p1);
}
__device__ __forceinline__ void finishSM(f32x16& p0, f32x16& p1, float& l_reg, bf16x8& pa0, bf16x8& pa1, bf16x8& pa2, bf16x8& pa3) {
  float ps = 0;
#pragma unroll
  for (int r = 0; r < 16; ++r) ps += p0[r];
#pragma unroll
  for (int r = 0; r < 16; ++r) ps += p1[r];
  { auto rr = __builtin_amdgcn_permlane32_swap(__float_as_uint(ps), __float_as_uint(ps), false, false);
    ps = __uint_as_float(rr[0]) + __uint_as_float(rr[1]); }
  l_reg += ps;
#define PK4(P, BASE, OUT) do { unsigned a0 = cvt_pk_bf16(P[BASE + 0], P[BASE + 1]), a1 = cvt_pk_bf16(P[BASE + 2], P[BASE + 3]);   \
    unsigned b0 = cvt_pk_bf16(P[BASE + 4], P[BASE + 5]), b1 = cvt_pk_bf16(P[BASE + 6], P[BASE + 7]);                              \
    u32x4 w = {a0, a1, b0, b1}; OUT = *reinterpret_cast<bf16x8*>(&w); } while (0)
  PK4(p0, 0, pa0); PK4(p0, 8, pa1); PK4(p1, 0, pa2); PK4(p1, 8, pa3);
#undef PK4
}
__device__ __forceinline__ void qkt(f32x16& p0, f32x16& p1, const bf16_t* Ks, const bf16x8* qr, bf16x8 onesf, bf16x8 qext, int r32, int hi, int c) {
  const f32x16 z = {};
  p0 = __builtin_amdgcn_mfma_f32_32x32x16_bf16(onesf, qext, z, 0, 0, 0);
  p1 = __builtin_amdgcn_mfma_f32_32x32x16_bf16(onesf, qext, z, 0, 0, 0);
  const char* Kc = (const char*)Ks + c * 128;
#pragma unroll
  for (int d0 = 0; d0 < 4; ++d0) { const int cb = (d0 * 16 + hi * 8) * 2;
    bf16x8 b0 = *reinterpret_cast<const bf16x8*>(Kc + KSWZ(r32, cb));
    bf16x8 b1 = *reinterpret_cast<const bf16x8*>(Kc + KSWZ(32 + r32, cb));
    p0 = __builtin_amdgcn_mfma_f32_32x32x16_bf16(b0, qr[d0], p0, 0, 0, 0);
    p1 = __builtin_amdgcn_mfma_f32_32x32x16_bf16(b1, qr[d0], p1, 0, 0, 0); }
}
__device__ __forceinline__ int v_st(int k, int c) { const int kk = k; return ((kk >> 3) * 4 + (c >> 5)) * 512 + ((kk & 7) * 32 + (c & 31)) * 2; }
__device__ __forceinline__ int v_rd_base(int lane) { return ((lane & 3) << 3) | (((lane >> 2) & 3) << 6) | (((lane >> 4) & 1) << 5) | (((lane >> 5) & 1) << 8); }
constexpr int v_rd_off(int d0, int ks, int half) { return d0 * 512 + ks * 4096 + half * 2048; }
template <int OFF> __device__ __forceinline__ s16x4 tr_read(int vb) {
  s16x4 r; asm volatile("ds_read_b64_tr_b16 %0, %1 offset:%2" : "=&v"(r) : "v"(vb), "i"(OFF) : "memory"); return r;
}
template <int D0, bool EXP> __device__ __forceinline__ void pv_one(f32x16& od, int vb, bf16x8 pa0, bf16x8 pa1, bf16x8 pa2, bf16x8 pa3, f32x16& pe, f32x16& pf) {
  const s16x4 l0 = tr_read<v_rd_off(D0, 0, 0)>(vb), h0 = tr_read<v_rd_off(D0, 0, 1)>(vb), l1 = tr_read<v_rd_off(D0, 1, 0)>(vb), h1 = tr_read<v_rd_off(D0, 1, 1)>(vb);
  const s16x4 l2 = tr_read<v_rd_off(D0, 2, 0)>(vb), h2 = tr_read<v_rd_off(D0, 2, 1)>(vb), l3 = tr_read<v_rd_off(D0, 3, 0)>(vb), h3 = tr_read<v_rd_off(D0, 3, 1)>(vb);
  asm volatile("s_waitcnt lgkmcnt(0)" ::: "memory"); SBAR();
#define PK(L, H) (bf16x8){L[0], L[1], L[2], L[3], H[0], H[1], H[2], H[3]}
  od = __builtin_amdgcn_mfma_f32_32x32x16_bf16(pa0, PK(l0, h0), od, 0, 0, 0);
  if (EXP) { pe[4 * D0 + 0] = __builtin_amdgcn_exp2f(pe[4 * D0 + 0]); pf[4 * D0 + 0] = __builtin_amdgcn_exp2f(pf[4 * D0 + 0]); }
  od = __builtin_amdgcn_mfma_f32_32x32x16_bf16(pa1, PK(l1, h1), od, 0, 0, 0);
  if (EXP) { pe[4 * D0 + 1] = __builtin_amdgcn_exp2f(pe[4 * D0 + 1]); pf[4 * D0 + 1] = __builtin_amdgcn_exp2f(pf[4 * D0 + 1]); }
  od = __builtin_amdgcn_mfma_f32_32x32x16_bf16(pa2, PK(l2, h2), od, 0, 0, 0);
  if (EXP) { pe[4 * D0 + 2] = __builtin_amdgcn_exp2f(pe[4 * D0 + 2]); pf[4 * D0 + 2] = __builtin_amdgcn_exp2f(pf[4 * D0 + 2]); }
  od = __builtin_amdgcn_mfma_f32_32x32x16_bf16(pa3, PK(l3, h3), od, 0, 0, 0);
  if (EXP) { pe[4 * D0 + 3] = __builtin_amdgcn_exp2f(pe[4 * D0 + 3]); pf[4 * D0 + 3] = __builtin_amdgcn_exp2f(pf[4 * D0 + 3]); }
#undef PK
}
template <bool EXP> __device__ __forceinline__ void pv_d0(f32x16* o, int vb, bf16x8 pa0, bf16x8 pa1, bf16x8 pa2, bf16x8 pa3, f32x16& pe, f32x16& pf) {
  pv_one<0, EXP>(o[0], vb, pa0, pa1, pa2, pa3, pe, pf); pv_one<1, EXP>(o[1], vb, pa0, pa1, pa2, pa3, pe, pf); pv_one<2, EXP>(o[2], vb, pa0, pa1, pa2, pa3, pe, pf); pv_one<3, EXP>(o[3], vb, pa0, pa1, pa2, pa3, pe, pf);
}

__device__ __forceinline__ void attn_pass(const bf16_t* Qb, const bf16_t* Kh, const bf16_t* Vh, int seq, int q0, int c, char* lds, const float* tab, f32x16 (&o)[4], float& l_out) {
  const int tid = otid(), wid = tid >> 6, lane = tid & 63, r32 = lane & 31, hi = lane >> 5;
  bf16_t* V_lds = (bf16_t*)lds; bf16_t* K_lds = (bf16_t*)(lds + 2 * SHM_V);
  float l_reg = 0, Mrow = 0.f;
#pragma unroll
  for (int d = 0; d < 4; ++d) o[d] = f32x16{};
  bf16x8 qr[4];
  const bf16_t* Qw = Qb + (size_t)(wid * 32 + r32) * LD + hi * 8;
#pragma unroll
  for (int d0 = 0; d0 < 4; ++d0) qr[d0] = *reinterpret_cast<const bf16x8*>(Qw + d0 * 16);
  const int sr = tid >> 4, sc = (tid & 15) * 8, vst0 = v_st(sr, sc), vst1 = v_st(32 + sr, sc);
  const int vb0 = (int)(uintptr_t)V_lds + v_rd_base(lane);
  const int qw0 = q0 + wid * 32, qrow = qw0 + r32;
  struct { bf16x8 vs0, vs1, ks0, ks1; } sr_[1];
#define SLOAD(i, k0) do { sr_[i].vs0 = *(const bf16x8*)(&Vh[(size_t)((k0) + sr) * LD + sc]); sr_[i].vs1 = *(const bf16x8*)(&Vh[(size_t)((k0) + 32 + sr) * LD + sc]); \
    sr_[i].ks0 = *(const bf16x8*)(&Kh[(size_t)((k0) + sr) * LD + sc]); sr_[i].ks1 = *(const bf16x8*)(&Kh[(size_t)((k0) + 32 + sr) * LD + sc]); } while (0)
#define SWRITE(b, i) do { *(bf16x8*)((char*)V_lds + (b) * SHM_V + vst0) = sr_[i].vs0;          \
    *(bf16x8*)((char*)V_lds + (b) * SHM_V + vst1) = sr_[i].vs1; int kc = sc * 2;               \
    *(bf16x8*)((char*)K_lds + (b) * SHM_K + KSWZ(sr, kc)) = sr_[i].ks0;                       \
    *(bf16x8*)((char*)K_lds + (b) * SHM_K + KSWZ(32 + sr, kc)) = sr_[i].ks1; } while (0)
#define SWAIT() asm volatile("s_waitcnt vmcnt(0)" ::: "memory")
  float bneg = 0.f, bpos = 0.f;
  unsigned wneg = 0u, wnear = 0u, wpos = 0u;
  bf16x8 onesf;
  { const u32x4 w = {hi == 0 ? 0x3f803f80u : 0u, 0u, 0u, 0u}; onesf = *reinterpret_cast<const bf16x8*>(&w); }
  u32x4 qw4 = {0u, 0u, 0u, 0u};
#define QEXT() (*reinterpret_cast<const bf16x8*>(&qw4))
#define NEARQ(t) (((t) * KVBLK + 63 - qw0 > -128) && ((t) * KVBLK - (qw0 + 31) < 128))
#define BCONST(t) (NEARQ(t) ? 0.f : ((t) * KVBLK > qw0 ? bpos : bneg))
#define MKW(bc) ([&]() -> unsigned { const float _off = (bc) - Mrow; const float _oh = __uint_as_float((cvt_pk_bf16(_off, 0.f) & 0xffffu) << 16); return hi == 0 ? cvt_pk_bf16(_off, _off - _oh) : 0u; }())
#define PREP(t) do { qw4.x = NEARQ(t) ? wnear : ((t) * KVBLK > qw0 ? wpos : wneg); } while (0)
#define PSB(P0, P1, t) do { if (NEARQ(t)) tileBias(P0, P1, tab + ((t) * KVBLK - qrow + 224 + 4 * hi)); } while (0)
  f32x16 pA0, pA1, pB0, pB1; bf16x8 pa0, pa1, pa2, pa3; const int NT = seq / KVBLK;
  constexpr int SE = 0, SO = 0;
  SLOAD(SE, 0); asm volatile("s_waitcnt vmcnt(0)" ::: "memory"); SWRITE(0, SE); __syncthreads();
  bneg = __uint_as_float(__builtin_amdgcn_readfirstlane(__float_as_uint(tab[0]))); bpos = __uint_as_float(__builtin_amdgcn_readfirstlane(__float_as_uint(tab[448])));
  SLOAD(SO, KVBLK); SBAR();
  qkt(pA0, pA1, K_lds, qr, onesf, QEXT(), r32, hi, c);
  firstSM(pA0, pA1, Mrow, NEARQ(0), BCONST(0), tab + (0 - qrow + 224 + 4 * hi));
  wneg = MKW(bneg); wnear = MKW(0.f); wpos = MKW(bpos);
  SWAIT(); SWRITE(1, SO); __syncthreads();
  for (int j = 1; j + 1 < NT; j += 2) {
    SBAR(); PREP(j); qkt(pB0, pB1, (bf16_t*)((char*)K_lds + SHM_K), qr, onesf, QEXT(), r32, hi, c);
    finishSM(pA0, pA1, l_reg, pa0, pa1, pa2, pa3); SBAR();
    SLOAD(SO, (j + 1) * KVBLK); SBAR();
    PSB(pB0, pB1, j); pv_d0<true>(o, vb0, pa0, pa1, pa2, pa3, pB0, pB1);
    __syncthreads(); SWAIT(); SWRITE(0, SE);
    __syncthreads();
    SBAR(); PREP(j + 1); qkt(pA0, pA1, K_lds, qr, onesf, QEXT(), r32, hi, c);
    finishSM(pB0, pB1, l_reg, pa0, pa1, pa2, pa3); SBAR();
    SLOAD(SE, (j + 2) * KVBLK); SBAR();
    PSB(pA0, pA1, j + 1); pv_d0<true>(o, vb0 + (int)SHM_V, pa0, pa1, pa2, pa3, pA0, pA1);
    __syncthreads(); SWAIT(); SWRITE(1, SO);
    __syncthreads();
  }
  SBAR(); PREP(NT - 1); qkt(pB0, pB1, (bf16_t*)((char*)K_lds + SHM_K), qr, onesf, QEXT(), r32, hi, c);
  finishSM(pA0, pA1, l_reg, pa0, pa1, pa2, pa3); SBAR();
  PSB(pB0, pB1, NT - 1); pv_d0<true>(o, vb0, pa0, pa1, pa2, pa3, pB0, pB1);
  __syncthreads();
  finishSM(pB0, pB1, l_reg, pa0, pa1, pa2, pa3); SBAR();
  pv_d0<false>(o, vb0 + (int)SHM_V, pa0, pa1, pa2, pa3, pB0, pB1);
  l_out = l_reg;
#undef SLOAD
#undef SWRITE
#undef SWAIT
#undef PSB
#undef PREP
#undef MKW
#undef QEXT
#undef BCONST
#undef NEARQ
}
}

__device__ void phase_attn(const Params& p, unsigned char* shm) {
  using namespace at;
  const int tid = otid(), wid = tid >> 6, lane = tid & 63, r32 = lane & 31, hi = lane >> 5, G = ogrid(), bid = obid();
  char* lds = (char*)shm;
  float* wsl = (float*)(lds + 2 * SHM_V + 2 * SHM_K) + wid * 64; float* li_l = wsl;
  float* tab = (float*)(lds + 2 * SHM_V + 2 * SHM_K + 8 * 64 * 4);
  const bf16_t* proj = (const bf16_t*)(p.ws + WS_PROJ); bf16_t* mix = (bf16_t*)(p.ws + WS_MIX);
  float* stash = (float*)((unsigned char*)p.out + OUT_STASH) + (size_t)bid * (64 * 512);
  const float* tabg = (const float*)(p.ws + WS_TAB);
  const float lam = ((const float*)(p.ws + WS_CONST))[0];
  unsigned* qctr = (unsigned*)(p.ws + WS_QCTR); volatile unsigned* nextw = (volatile unsigned*)(shm + LDS_BYTES - 32);
  int it = bid;
  while (it < 2048) {
    int tb, S, h, qb;
    if (it < 1024) { const int b = it >> 9; h = (it >> 6) & 7; qb = it & 63; tb = TOKP + b * SS; S = SS; }
    else { const int u = it - 1024, b = u >> 6; h = (u >> 3) & 7; qb = u & 7; tb = b * SP; S = SP; }
    const int q0 = qb * 256;
    __syncthreads();
    if (tid < 449) { int j = tid - 96; j = j < 0 ? 0 : (j > 256 ? 256 : j); tab[tid] = tabg[h * 257 + j]; }
    const bf16_t* Kh = proj + (size_t)tb * PW + 3072 + h * 128; const bf16_t* Vh = proj + (size_t)tb * PW + 4096 + h * 128;
    const bf16_t* Qb = proj + (size_t)(tb + q0) * PW + 2048 + h * 128;
    f32x16 o[4]; float l_reg;
#pragma nounroll
    for (int c = 0; c < 2; ++c) {
      attn_pass(Qb + c * 64, Kh, Vh, S, q0, c, lds, tab, o, l_reg);
      int hi_e = hi, r32_e = r32; asm volatile("" : "+v"(hi_e), "+v"(r32_e));
      if (hi == 0) li_l[r32] = l_reg; asm volatile("s_waitcnt lgkmcnt(0)" ::: "memory");
      const float* li_h = li_l + 4 * hi_e;
      if (c == 0) {
#pragma unroll
        for (int r = 0; r < 16; ++r) { const float rl = __builtin_amdgcn_rcpf(li_h[crow(r, 0)]);
          *(f32x4*)(stash + tid * 64 + r * 4) = (f32x4){o[0][r] * rl, o[1][r] * rl, o[2][r] * rl, o[3][r] * rl}; }
      } else {
        float sg[4];
#pragma unroll
        for (int d0 = 0; d0 < 4; ++d0) sg[d0] = p.subg[d0 * 32 + r32_e] * 0.8f;
        bf16_t* ob = mix + (size_t)(tb + q0 + wid * 32 + 4 * hi_e) * DM + 1024 + h * 128 + r32_e;
#pragma unroll
        for (int r = 0; r < 16; ++r) { const float rl = __builtin_amdgcn_rcpf(li_h[crow(r, 0)]) * lam; float v[4]; float sq = 0.f;
          const f32x4 st = *(const f32x4*)(stash + tid * 64 + r * 4);
#pragma unroll
          for (int d0 = 0; d0 < 4; ++d0) { v[d0] = st[d0] - o[d0][r] * rl; sq += v[d0] * v[d0]; }
          sq += __shfl_xor(sq, 1); sq += __shfl_xor(sq, 2); sq += __shfl_xor(sq, 4); sq += __shfl_xor(sq, 8); sq += __shfl_xor(sq, 16);
          const float rn = rsqrtf(sq * (1.f / 128.f) + EPS);
#pragma unroll
          for (int d0 = 0; d0 < 4; ++d0) ob[(size_t)crow(r, 0) * DM + d0 * 32] = f2bf(v[d0] * rn * sg[d0]); }
      }
    }
    __syncthreads();
    if (tid == 0) nextw[0] = (unsigned)G + atomicAdd(qctr, 1u);
    __syncthreads();
    it = __builtin_amdgcn_readfirstlane((int)nextw[0]);
  }
}

__device__ void phase_final(const Params& p) {
  const int tid = otid(), G = ogrid(), bid = obid(), wid = tid >> 6, lane = tid & 63;
  const float* ss3 = (const float*)(p.ws + WS_SS) + NTOK; const bf16_t* x2 = (const bf16_t*)(p.ws + WS_X1B);
  for (int row = bid * 8 + wid; row < NTOK; row += G * 8) {
    const float r = rsqrtf(ss3[row] * (1.f / DM) + EPS); const bf16_t* xr = x2 + (size_t)row * DM; float* orow = p.out + (size_t)row * DM;
#pragma unroll
    for (int it = 0; it < 4; ++it) { const int c = it * 512 + lane * 8; const u32x4 w = *(const u32x4*)(xr + c);
      const f32x4 g0 = *(const f32x4*)(p.fg + c), g1 = *(const f32x4*)(p.fg + c + 4);
      const f32x4 a = {__uint_as_float(w.x << 16), __uint_as_float(w.x & 0xffff0000u), __uint_as_float(w.y << 16), __uint_as_float(w.y & 0xffff0000u)};
      const f32x4 b = {__uint_as_float(w.z << 16), __uint_as_float(w.z & 0xffff0000u), __uint_as_float(w.w << 16), __uint_as_float(w.w & 0xffff0000u)};
      *(f32x4*)(orow + c) = a * r * g0; *(f32x4*)(orow + c + 4) = b * r * g1; }
  }
}

#define XB_TMO      128
#define XB_XCNT(j)  (256  + 64 * (j))
#define XB_XSUB(j)  (1280 + 64 * (j))
#define XB_XGEN(j)  (2304 + 64 * (j))
#define XB_TOP      3328
#define XB_TOPGEN   3392
#define XCD_BAR_WORDS 3456
#define XB_SPIN_CAP (1u << 18)
__device__ __forceinline__ unsigned xb_ld(unsigned* p)              { return __hip_atomic_load(p, __ATOMIC_RELAXED, __HIP_MEMORY_SCOPE_AGENT); }
__device__ __forceinline__ unsigned xb_add(unsigned* p, unsigned v) { return __hip_atomic_fetch_add(p, v, __ATOMIC_RELAXED, __HIP_MEMORY_SCOPE_AGENT); }
__device__ __forceinline__ unsigned xb_xcc_id() { return (unsigned)__builtin_amdgcn_s_getreg((3 << 11) | 20) & 0xFu; }
#define XB_SPIN(cond, bar) do { unsigned _sp = 0; while (cond) { __builtin_amdgcn_s_sleep(1); \
    if ((++_sp & 255u) == 0u) { if (xb_ld(&(bar)[XB_TMO])) break; if (_sp > XB_SPIN_CAP) { atomicAdd(&(bar)[XB_TMO], 1u); break; } } } } while (0)
struct XcdBarrier { unsigned* bar; unsigned x; volatile LAS unsigned* st; };
__device__ __forceinline__ XcdBarrier xcd_barrier_post(unsigned* bar, volatile LAS unsigned* st) {
  XcdBarrier b; b.bar = bar; b.x = xb_xcc_id(); b.st = st;
  if (threadIdx.x == 0) (void)xb_add(&bar[XB_XCNT(b.x)], 1u);
  return b;
}
__device__ __forceinline__ void xcd_barrier_complete(unsigned* bar, unsigned x, unsigned& nloc, unsigned& nx) {
  const unsigned G = gridDim.x * gridDim.y * gridDim.z;
  unsigned sum, cnt, mine, sp = 0u;
  for (;;) {
    sum = 0u; cnt = 0u; mine = 0u;
#pragma unroll
    for (unsigned j = 0; j < 16; ++j) { const unsigned c = xb_ld(&bar[XB_XCNT(j)]); sum += c; cnt += (c > 0u) ? 1u : 0u; mine = (j == x) ? c : mine; }
    if (sum == G) break;
    __builtin_amdgcn_s_sleep(1);
    if ((++sp & 255u) == 0u) { if (xb_ld(&bar[XB_TMO])) break; if (sp > XB_SPIN_CAP) { atomicAdd(&bar[XB_TMO], 1u); break; } }
  }
  nloc = mine > 0u ? mine : 1u; nx = cnt > 0u ? cnt : 1u;
}
__device__ __forceinline__ void xcd_barrier(const XcdBarrier& b) {
  asm volatile("s_waitcnt vmcnt(0)" ::: "memory");
  __syncthreads();
  if (threadIdx.x == 0) {
    unsigned* bar = b.bar;
    __builtin_amdgcn_s_waitcnt(0);
    unsigned nloc = b.st[0], nx = b.st[1];
    if (nloc == 0u) { xcd_barrier_complete(bar, b.x, nloc, nx); b.st[0] = nloc; b.st[1] = nx; }
    const unsigned old = xb_add(&bar[XB_XSUB(b.x)], 1u);
    const unsigned gen = old / nloc;
    if (old + 1u == (gen + 1u) * nloc) {
      __builtin_amdgcn_fence(__ATOMIC_RELEASE, "agent");
      asm volatile("s_waitcnt vmcnt(0)" ::: "memory");
      const unsigned og = xb_add(&bar[XB_TOP], 1u);
      const unsigned tg = og / nx;
      if (og + 1u == (tg + 1u) * nx) xb_add(&bar[XB_TOPGEN], 1u);
      else XB_SPIN(xb_ld(&bar[XB_TOPGEN]) == tg, bar);
      __builtin_amdgcn_fence(__ATOMIC_ACQUIRE, "agent");
      xb_add(&bar[XB_XGEN(b.x)], 1u);
      asm volatile("s_waitcnt vmcnt(0)" ::: "memory");
    } else {
      XB_SPIN(xb_ld(&bar[XB_XGEN(b.x)]) == gen, bar);
      __builtin_amdgcn_fence(__ATOMIC_ACQUIRE, "agent");
      asm volatile("s_waitcnt vmcnt(0)" ::: "memory");
    }
  }
  __syncthreads();
}

constexpr int NPHASE = 11;
__global__ __launch_bounds__(512, 2) void mega(Params p) {
  extern __shared__ __attribute__((aligned(16))) unsigned char shm[];
  unsigned char* ws = p.ws;
#define PHASE(ph) if (p.ph_lo <= (ph) && (ph) < p.ph_hi)
  XcdBarrier xbar; xbar.bar = (unsigned*)(ws + WS_BAR); xbar.x = 0; xbar.st = (volatile LAS unsigned*)(shm + LDS_BYTES - 16);
  if (p.ph_hi - p.ph_lo > 2) { if (threadIdx.x == 0) { xbar.st[0] = 0u; xbar.st[1] = 0u; } __syncthreads(); xbar = xcd_barrier_post((unsigned*)(ws + WS_BAR), (volatile LAS unsigned*)(shm + LDS_BYTES - 16)); }
#define SEAM(ph) do { if ((ph) > p.ph_lo && (ph) < p.ph_hi) { if (p.ph_lo < 0) cg::this_grid().sync(); else xcd_barrier(xbar); } } while (0)
  PHASE(0) phase_prep(p, shm);
  SEAM(1);
  PHASE(1) phase_fold(p, shm);
  SEAM(2);
  PHASE(2) { pg8::Gemm g{(const bf16_t*)((unsigned char*)p.out + OUT_XB), (const bf16_t*)(ws + WS_WIN), NTOK, PW, DM};
    pg8::StaticOrder S; S.init(g.M, g.N, ogrid(), obid()); EpiProj E{(bf16_t*)(ws + WS_PROJ), (const float*)(ws + WS_RS1)};
    pg8::gemm_phase((LAS unsigned char*)shm, g, S, E); }
  SEAM(3);
  PHASE(3) { fourier_stage1((const bf16_t*)(ws + WS_PROJ), (bf16_t*)((unsigned char*)p.out + OUT_T), shm); phase_attn(p, shm); }
  SEAM(4);
  PHASE(4) { fourier_stage2<128, 128>((const bf16_t*)((unsigned char*)p.out + OUT_T), (bf16_t*)(ws + WS_MIX), TOKP, BS, shm);
    fourier_stage2<16, 1024>((const bf16_t*)((unsigned char*)p.out + OUT_T), (bf16_t*)(ws + WS_MIX), 0, BP, shm); }
  SEAM(5);
  PHASE(5) { pg8::Gemm g{(const bf16_t*)(ws + WS_MIX), (const bf16_t*)(ws + WS_WOUT), NTOK, DM, DM};
    pg8::StaticOrder S; S.init(g.M, g.N, ogrid(), obid()); EpiOut E{p.xp, p.xs, p.out, (bf16_t*)(ws + WS_X1B), (float*)(ws + WS_SS)};
    pg8::gemm_phase((LAS unsigned char*)shm, g, S, E); }
#pragma nounroll
  for (int half = 0; half < 2; ++half) {
    const int ph1 = 6 + 2 * half, ph2 = 7 + 2 * half;
    SEAM(ph1);
    PHASE(ph1) { pg8::Gemm g{(const bf16_t*)(ws + WS_X1B) + (size_t)half * TOKP * DM, (const bf16_t*)(ws + WS_WGU), TOKP, 2 * DFF, DM};
      pg8::StaticOrder S; S.init(g.M, g.N, ogrid(), obid()); EpiFfn1 E{(bf16_t*)(ws + WS_ACT), (const float*)(ws + WS_SS), half * TOKP};
      pg8::gemm_phase((LAS unsigned char*)shm, g, S, E); }
    SEAM(ph2);
    PHASE(ph2) { pg8::Gemm g{(const bf16_t*)(ws + WS_ACT), (const bf16_t*)(ws + WS_WD), TOKP, DM, DFF};
      pg8::StaticOrder S; S.init(g.M, g.N, ogrid(), obid()); EpiFfn2 E{(bf16_t*)(ws + WS_X1B), (float*)(ws + WS_SS) + NTOK, half * TOKP};
      pg8::gemm_phase((LAS unsigned char*)shm, g, S, E); }
  }
  SEAM(10);
  PHASE(10) phase_final(p);
}

extern "C" void kernel_launch(void* const* d_in, const int* in_sizes, int n_in, void* d_out, int out_size, void* d_ws, size_t ws_size, hipStream_t stream) {
  static int grid = 0;
  if (grid == 0) {
    if (n_in != 17 || in_sizes[0] != BP * SP * DM || in_sizes[1] != BS * SS * DM || out_size != NTOK * DM || ws_size < WS_END) {
      fprintf(stderr, "kernel_launch: unexpected shapes (n_in %d, ws %zu)\n", n_in, ws_size); grid = -1; return; }
    int dev = 0, cus = 0, per_cu = 0;
    hipGetDevice(&dev); hipDeviceGetAttribute(&cus, hipDeviceAttributeMultiprocessorCount, dev);
    if (hipFuncSetAttribute((const void*)mega, hipFuncAttributeMaxDynamicSharedMemorySize, LDS_BYTES) != hipSuccess) { fprintf(stderr, "kernel_launch: hipFuncSetAttribute failed\n"); grid = -1; return; }
    if (hipOccupancyMaxActiveBlocksPerMultiprocessor(&per_cu, (const void*)mega, 512, LDS_BYTES) != hipSuccess || per_cu < 1) { fprintf(stderr, "kernel_launch: occupancy query gave %d\n", per_cu); per_cu = 1; }
    (void)hipGetLastError();
    grid = cus * 1;
  }
  if (grid < 0) return;
  Params p{};
  p.xp = (const float*)d_in[0]; p.xs = (const float*)d_in[1]; p.g1 = (const float*)d_in[2]; p.w_in = (const float*)d_in[3]; p.w_f = (const float*)d_in[4];
  p.lq1 = (const float*)d_in[5]; p.lk1 = (const float*)d_in[6]; p.lq2 = (const float*)d_in[7]; p.lk2 = (const float*)d_in[8]; p.subg = (const float*)d_in[9];
  p.w_out = (const float*)d_in[10]; p.g2 = (const float*)d_in[11]; p.w_gate = (const float*)d_in[12]; p.w_up = (const float*)d_in[13]; p.w_down = (const float*)d_in[14];
  p.relb = (const float*)d_in[15]; p.fg = (const float*)d_in[16];
  p.out = (float*)d_out; p.ws = (unsigned char*)d_ws;
#if ONE_LAUNCH
  if (hipMemsetAsync((unsigned char*)d_ws + WS_BAR, 0, XCD_BAR_WORDS * 4 + 256, stream) != hipSuccess) { fprintf(stderr, "kernel_launch: memset of the barrier words failed\n"); return; }
  p.ph_lo = 0; p.ph_hi = NPHASE;
  void* args[] = {&p};
  hipError_t e = hipLaunchCooperativeKernel((const void*)mega, dim3(grid), dim3(512), args, LDS_BYTES, stream);
  if (e != hipSuccess) fprintf(stderr, "cooperative launch failed: %s (grid %d)\n", hipGetErrorString(e), grid);
#else
  for (int ph = 0; ph < NPHASE; ++ph) { p.ph_lo = ph; p.ph_hi = ph + 1; hipLaunchKernelGGL(mega, dim3(grid), dim3(512), LDS_BYTES, stream, p); }
#endif
}
```

```cpp
#include <hip/hip_runtime.h>
#include <hip/hip_cooperative_groups.h>
#include <cstdio>
#include <cstdint>
namespace cg = cooperative_groups;

#ifndef ONE_LAUNCH
#define ONE_LAUNCH 1
#endif

typedef unsigned short bf16_t;
typedef short bf16x8 __attribute__((ext_vector_type(8)));
typedef short s16x4 __attribute__((ext_vector_type(4)));
typedef float f32x4 __attribute__((ext_vector_type(4)));
typedef float f32x8 __attribute__((ext_vector_type(8)));
typedef float f32x16 __attribute__((ext_vector_type(16)));
typedef unsigned u32x4 __attribute__((ext_vector_type(4)));
typedef unsigned u32x2 __attribute__((ext_vector_type(2)));
#define LAS __attribute__((address_space(3)))

constexpr int DM = 2048, NTOK = 65536, TOKP = 32768, SP = 2048, BP = 16, SS = 16384, BS = 2;
constexpr int PW = 5120;
constexpr int DFF = 5632;
constexpr float EPS = 1e-6f, LOG2E = 1.4426950408889634f;
constexpr size_t MiB = 1024 * 1024;
constexpr size_t WS_WIN = 0, WS_WOUT = 20 * MiB, WS_WGU = 28 * MiB, WS_WD = 72 * MiB, WS_SMALL = 94 * MiB;
constexpr size_t WS_AB = WS_SMALL, WS_RS1 = WS_SMALL + 1 * MiB, WS_SS = WS_RS1 + 256 * 1024  , WS_CONST = WS_SS + 512 * 1024, WS_TAB = WS_CONST + 4096, WS_BAR = WS_TAB + 16384  , WS_QCTR = WS_BAR + 3456 * 4  ;
constexpr size_t WS_PROJ = 100 * MiB, WS_MIX = 740 * MiB, WS_END = 996 * MiB;
constexpr size_t WS_X1B = WS_PROJ, WS_ACT = WS_PROJ + 256 * MiB;
constexpr size_t OUT_XB = 0, OUT_STASH = 0, OUT_T = 256 * MiB;
constexpr int LDS_BYTES = 140 * 1024;

struct Params {
  const float *xp, *xs, *g1, *w_in, *w_f, *lq1, *lk1, *lq2, *lk2, *subg, *w_out, *g2, *w_gate, *w_up, *w_down, *relb, *fg;
  float* out; unsigned char* ws; int ph_lo, ph_hi;
};

__device__ __forceinline__ int otid() { int t = threadIdx.x; asm volatile("" : "+v"(t)); return t; }
__device__ __forceinline__ int obid() { int t = blockIdx.x; asm volatile("" : "+v"(t)); return __builtin_amdgcn_readfirstlane(t); }
__device__ __forceinline__ int ogrid() { int t = gridDim.x; asm volatile("" : "+v"(t)); return __builtin_amdgcn_readfirstlane(t); }
__device__ __forceinline__ unsigned cvt_pk_bf16(float lo, float hi) { unsigned r; asm volatile("v_cvt_pk_bf16_f32 %0, %1, %2" : "=v"(r) : "v"(lo), "v"(hi)); return r; }
__device__ __forceinline__ bf16_t f2bf(float x) { return (bf16_t)(cvt_pk_bf16(x, 0.f) & 0xffffu); }

namespace pg8 {
constexpr int BM = 256, BK = 64, HALF = 128, HTB = HALF * BK * 2, STAGE_BYTES = 8 * HTB, NXCD = 8, WGM = 8;
__device__ __forceinline__ int lds_byte(int r, int c) { const int st = (r >> 4) * 2 + (c >> 5), rr = r & 15, cc = c & 31, ob = rr * 64 + cc * 2; return st * 1024 + (ob ^ (((ob >> 9) & 1) << 5)); }
__device__ __forceinline__ void stage_rc(int b, int& R, int& C) { const int st = b / 1024, sb = b % 1024, swz = sb ^ (((sb >> 9) & 1) << 5); R = (st >> 1) * 16 + swz / 64; C = (st & 1) * 32 + (swz % 64) / 2; }
__device__ __forceinline__ int perm32(int rho) { const int n = rho >> 4, i = rho & 15; return 8 * (i >> 2) + 4 * n + (i & 3); }
struct Unit { int pm, pn; };
struct Gemm { const bf16_t* A; const bf16_t* Bt; int M, N, K; };
struct StaticOrder {
  int nM, nN, nwg, G, c;
  __device__ void init(int M, int N, int G_, int c_) { nM = M / BM; nN = N / BM; nwg = nM * nN; G = G_; c = c_; }
  __device__ bool next(int i, Unit& u) const {
    const long L = (long)i * G + c; if (L >= nwg) return false;
    int wgid = (int)L; { const int q = nwg / NXCD, r = nwg % NXCD, xcd = wgid % NXCD, off = wgid / NXCD; wgid = (xcd < r ? xcd * (q + 1) : r * (q + 1) + (xcd - r) * q) + off; }
    const int nig = WGM * nN, gid = wgid / nig, fm = gid * WGM, gsz = (nM - fm) < WGM ? (nM - fm) : WGM;
    u.pm = fm + ((wgid % nig) % gsz); u.pn = (wgid % nig) / gsz; return true;
  }
};
template <class Epi>
__device__ __forceinline__ void gemm_phase(LAS unsigned char* lds, const Gemm g, const StaticOrder& S, const Epi& E) {
  const int tid = otid(), wid = __builtin_amdgcn_readfirstlane(tid >> 6), lane = tid & 63, wr = wid >> 2, wc = wid & 3, fr = lane & 15, fq = lane >> 4;
  const int K = g.K, nt = K / BK;
  unsigned voffA[2], voffB[2];
#pragma unroll
  for (int i = 0; i < 2; ++i) { int R, C; stage_rc(tid * 16 + i * 8192, R, C); const int Rb = Epi::PERM ? ((R & ~31) + perm32(R & 31)) : R;
    voffA[i] = (unsigned)(R * K + C) * 2u; voffB[i] = (unsigned)(Rb * K + C) * 2u; }
  const size_t kstep = (size_t)(BK * 2);
  const size_t hstep = (size_t)HALF * K * 2;
  const size_t tstep = 2 * hstep;
  const unsigned ldsw = (unsigned)wid * 1024u;
  const int aoff = lds_byte(wr * 64 + fr, fq * 8), boff = lds_byte(wc * 32 + fr, fq * 8);
#define PG8_SA(b, h) (((b) * 2 + (h)) * HTB)
#define PG8_SB(b, h) ((4 + (b) * 2 + (h)) * HTB)
#define PG8_STAGE(bufoff, gbase, voff) do { _Pragma("unroll") for (int _i = 0; _i < 2; ++_i) \
    __builtin_amdgcn_global_load_lds((const unsigned*)((const char*)(gbase) + (voff)[_i]), (LAS unsigned*)(lds + (bufoff) + ldsw + _i * 8192), 16, 0, 0); } while (0)
#define PG8_LDA(dst, b, h) do { _Pragma("unroll") for (int m = 0; m < 4; ++m) _Pragma("unroll") for (int k = 0; k < 2; ++k) dst[m][k] = *(const LAS bf16x8*)(lds + PG8_SA(b, h) + aoff + m * 2048 + k * 1024); } while (0)
#define PG8_LDB(dst, b, h) do { _Pragma("unroll") for (int n = 0; n < 2; ++n) _Pragma("unroll") for (int k = 0; k < 2; ++k) dst[n][k] = *(const LAS bf16x8*)(lds + PG8_SB(b, h) + boff + n * 2048 + k * 1024); } while (0)
#define PG8_MMA(ai, bj, At, Bt) do { __builtin_amdgcn_s_setprio(1); _Pragma("unroll") for (int m = 0; m < 4; ++m) _Pragma("unroll") for (int n = 0; n < 2; ++n) _Pragma("unroll") for (int k = 0; k < 2; ++k) \
    acc[ai][bj][m][n] = __builtin_amdgcn_mfma_f32_16x16x32_bf16(Bt[n][k], At[m][k], acc[ai][bj][m][n], 0, 0, 0); __builtin_amdgcn_s_setprio(0); } while (0)
#define PG8_WAIT_V(n) asm volatile("s_waitcnt vmcnt(" #n ")" ::: "memory")
#define PG8_WAIT_L(n) asm volatile("s_waitcnt lgkmcnt(" #n ")" ::: "memory")
#define PG8_BAR __builtin_amdgcn_s_barrier()
#define PG8_SCHED __builtin_amdgcn_sched_barrier(0)
  Unit cur, nxt; int ui = 0;
  if (!S.next(0, cur)) return;
  f32x4 acc[2][2][4][2];
#pragma unroll
  for (int a = 0; a < 2; ++a)
#pragma unroll
    for (int b = 0; b < 2; ++b)
#pragma unroll
      for (int m = 0; m < 4; ++m)
#pragma unroll
        for (int n = 0; n < 2; ++n) acc[a][b][m][n] = (f32x4){0.f, 0.f, 0.f, 0.f};
  bf16x8 At[4][2], B0[2][2], B1[2][2];
  const char* cA = (const char*)g.A + (size_t)cur.pm * tstep; const char* cB = (const char*)g.Bt + (size_t)cur.pn * tstep;
  PG8_STAGE(PG8_SB(0, 0), cB, voffB); PG8_STAGE(PG8_SB(0, 1), cB + hstep, voffB); PG8_STAGE(PG8_SA(0, 0), cA, voffA); PG8_STAGE(PG8_SA(0, 1), cA + hstep, voffA);
  if (wr == 1) PG8_BAR;
  PG8_WAIT_V(2); PG8_BAR;
  PG8_STAGE(PG8_SB(1, 0), cB + kstep, voffB); PG8_STAGE(PG8_SA(1, 0), cA + kstep, voffA); PG8_STAGE(PG8_SB(1, 1), cB + hstep + kstep, voffB);
  PG8_WAIT_V(6); PG8_BAR;
  for (;;) {
    const bool has_next = S.next(ui + 1, nxt);
    const char* nA = has_next ? (const char*)g.A + (size_t)nxt.pm * tstep : cA; const char* nB = has_next ? (const char*)g.Bt + (size_t)nxt.pn * tstep : cB;
    for (int t = 0; t < nt; t += 2) {
      const bool last = (t == nt - 2);
      const char* a1 = cA + (size_t)(t + 1) * kstep;
      const char* a2 = last ? nA : cA + (size_t)(t + 2) * kstep; const char* b2 = last ? nB : cB + (size_t)(t + 2) * kstep;
      const char* a3 = a2 + kstep; const char* b3 = b2 + kstep;
      PG8_LDB(B0, 0, 0); PG8_LDB(B1, 0, 1); PG8_SCHED; PG8_LDA(At, 0, 0); PG8_STAGE(PG8_SA(1, 1), a1 + hstep, voffA);
      PG8_WAIT_V(8); PG8_WAIT_L(0); PG8_BAR; PG8_MMA(0, 0, At, B0); PG8_MMA(0, 1, At, B1); PG8_BAR; PG8_SCHED;
      PG8_LDA(At, 0, 1); PG8_STAGE(PG8_SB(0, 0), b2, voffB); PG8_STAGE(PG8_SB(0, 1), b2 + hstep, voffB); PG8_STAGE(PG8_SA(0, 0), a2, voffA);
      PG8_WAIT_V(8); PG8_WAIT_L(0); PG8_BAR; PG8_MMA(1, 0, At, B0); PG8_MMA(1, 1, At, B1); PG8_BAR; PG8_SCHED;
      PG8_LDB(B0, 1, 0); PG8_LDB(B1, 1, 1); PG8_SCHED; PG8_LDA(At, 1, 0); PG8_STAGE(PG8_SA(0, 1), a2 + hstep, voffA);
      PG8_WAIT_V(8); PG8_WAIT_L(0); PG8_BAR; PG8_MMA(0, 0, At, B0); PG8_MMA(0, 1, At, B1); PG8_BAR; PG8_SCHED;
      PG8_LDA(At, 1, 1); PG8_STAGE(PG8_SB(1, 0), b3, voffB); PG8_STAGE(PG8_SB(1, 1), b3 + hstep, voffB); PG8_STAGE(PG8_SA(1, 0), a3, voffA);
      PG8_WAIT_V(8); PG8_WAIT_L(0); PG8_BAR; PG8_MMA(1, 0, At, B0); PG8_MMA(1, 1, At, B1); PG8_BAR; PG8_SCHED;
    }
    if (wr == 0) PG8_BAR;
    E(acc, cur, wr, wc, fr, fq);
    if (!has_next) break;
#pragma unroll
    for (int a = 0; a < 2; ++a)
#pragma unroll
      for (int b = 0; b < 2; ++b)
#pragma unroll
        for (int m = 0; m < 4; ++m)
#pragma unroll
          for (int n = 0; n < 2; ++n) acc[a][b][m][n] = (f32x4){0.f, 0.f, 0.f, 0.f};
    cur = nxt; cA = nA; cB = nB; ++ui;
    if (wr == 1) PG8_BAR;
  }
  PG8_WAIT_V(0);
  PG8_BAR;
#undef PG8_SA
#undef PG8_SB
#undef PG8_STAGE
#undef PG8_LDA
#undef PG8_LDB
#undef PG8_MMA
#undef PG8_WAIT_V
#undef PG8_WAIT_L
#undef PG8_BAR
#undef PG8_SCHED
}
}

struct EpiProj {
  static constexpr bool PERM = true;
  bf16_t* O; const float* rs;
  __device__ __forceinline__ void operator()(const f32x4 (&acc)[2][2][4][2], const pg8::Unit& u, int wr, int wc, int fr, int fq) const {
    const int row0 = u.pm * 256 + wr * 64 + fr, col0 = u.pn * 256 + wc * 32 + 8 * fq;
#pragma unroll
    for (int ai = 0; ai < 2; ++ai)
#pragma unroll
      for (int m = 0; m < 4; ++m) { const int row = row0 + ai * 128 + m * 16; const float s = rs[row]; bf16_t* rowp = O + (size_t)row * PW + col0;
#pragma unroll
        for (int bj = 0; bj < 2; ++bj) { const f32x4 v0 = acc[ai][bj][m][0] * s, v1 = acc[ai][bj][m][1] * s;
          u32x4 w; w.x = cvt_pk_bf16(v0[0], v0[1]); w.y = cvt_pk_bf16(v0[2], v0[3]); w.z = cvt_pk_bf16(v1[0], v1[1]); w.w = cvt_pk_bf16(v1[2], v1[3]);
          *(u32x4*)(rowp + bj * 128) = w; } }
  }
};
struct EpiOut {
  static constexpr bool PERM = false;
  const float* xp; const float* xs; float* x1; bf16_t* x1b; float* ss;
  __device__ __forceinline__ void operator()(const f32x4 (&acc)[2][2][4][2], const pg8::Unit& u, int wr, int wc, int fr, int fq) const {
    const int row0 = u.pm * 256 + wr * 64 + fr, col0 = u.pn * 256 + wc * 32 + 4 * fq;
#pragma unroll
    for (int ai = 0; ai < 2; ++ai)
#pragma unroll
      for (int m = 0; m < 4; ++m) { const int row = row0 + ai * 128 + m * 16;
        const float* xr = (row < TOKP ? xp + (size_t)row * DM : xs + (size_t)(row - TOKP) * DM) + col0;
        bf16_t* ob = x1b + (size_t)row * DM + col0; float sq = 0.f;
#pragma unroll
        for (int bj = 0; bj < 2; ++bj)
#pragma unroll
          for (int n = 0; n < 2; ++n) { const int c = bj * 128 + n * 16; const f32x4 v = acc[ai][bj][m][n] + *(const f32x4*)(xr + c);
            u32x2 w; w.x = cvt_pk_bf16(v[0], v[1]); w.y = cvt_pk_bf16(v[2], v[3]); *(u32x2*)(ob + c) = w;
            sq += v[0] * v[0] + v[1] * v[1] + v[2] * v[2] + v[3] * v[3]; }
        sq += __shfl_xor(sq, 16); sq += __shfl_xor(sq, 32);
        if (fq == 0) atomicAdd(ss + row, sq); }
  }
};
struct EpiFfn1 {
  static constexpr bool PERM = true;
  bf16_t* act; const float* ss2; int rowbase;
  __device__ __forceinline__ void operator()(const f32x4 (&acc)[2][2][4][2], const pg8::Unit& u, int wr, int wc, int fr, int fq) const {
    const int row0 = u.pm * 256 + wr * 64 + fr, col0 = u.pn * 128 + wc * 32 + 8 * fq;
#pragma unroll
    for (int ai = 0; ai < 2; ++ai)
#pragma unroll
      for (int m = 0; m < 4; ++m) { const int row = row0 + ai * 128 + m * 16; const float s = rsqrtf(ss2[rowbase + row] * (1.f / DM) + EPS);
        float a[8];
#pragma unroll
        for (int n = 0; n < 2; ++n)
#pragma unroll
          for (int j = 0; j < 4; ++j) { const float gg = acc[ai][0][m][n][j] * s, uu = acc[ai][1][m][n][j] * s;
            a[n * 4 + j] = gg * __builtin_amdgcn_rcpf(1.f + __expf(-gg)) * uu; }
        u32x4 w; w.x = cvt_pk_bf16(a[0], a[1]); w.y = cvt_pk_bf16(a[2], a[3]); w.z = cvt_pk_bf16(a[4], a[5]); w.w = cvt_pk_bf16(a[6], a[7]);
        *(u32x4*)(act + (size_t)row * DFF + col0) = w; }
  }
};
struct EpiFfn2 {
  static constexpr bool PERM = false;
  bf16_t* xb; float* ss; int rowbase;
  __device__ __forceinline__ void operator()(const f32x4 (&acc)[2][2][4][2], const pg8::Unit& u, int wr, int wc, int fr, int fq) const {
    const int row0 = rowbase + u.pm * 256 + wr * 64 + fr, col0 = u.pn * 256 + wc * 32 + 4 * fq;
#pragma unroll
    for (int ai = 0; ai < 2; ++ai)
#pragma unroll
      for (int m = 0; m < 4; ++m) { const int row = row0 + ai * 128 + m * 16; bf16_t* br = xb + (size_t)row * DM + col0; float sq = 0.f;
#pragma unroll
        for (int bj = 0; bj < 2; ++bj)
#pragma unroll
          for (int n = 0; n < 2; ++n) { const int c = bj * 128 + n * 16; const u32x2 w = *(const u32x2*)(br + c);
            const f32x4 r = {__uint_as_float(w.x << 16), __uint_as_float(w.x & 0xffff0000u), __uint_as_float(w.y << 16), __uint_as_float(w.y & 0xffff0000u)};
            const f32x4 v = acc[ai][bj][m][n] + r;
            u32x2 o; o.x = cvt_pk_bf16(v[0], v[1]); o.y = cvt_pk_bf16(v[2], v[3]); *(u32x2*)(br + c) = o;
            sq += v[0] * v[0] + v[1] * v[1] + v[2] * v[2] + v[3] * v[3]; }
        sq += __shfl_xor(sq, 16); sq += __shfl_xor(sq, 32);
        if (fq == 0) atomicAdd(ss + row, sq); }
  }
};

__device__ __forceinline__ void tconv_tile(const float* src, int ldsrc, const float* sk, float cs, bf16_t* dst, int ldd, int mode, int k0, int n0, float* tile) {
  const int tid = otid();
  __syncthreads();
  { const int nl = tid & 63, kl = tid >> 6;
#pragma unroll
    for (int p = 0; p < 8; ++p) tile[(kl + 8 * p) * 65 + nl] = src[(size_t)(k0 + kl + 8 * p) * ldsrc + n0 + nl]; }
  __syncthreads();
  { const int kl = tid & 63, nl = tid >> 6; const float s = (sk ? sk[k0 + kl] : 1.f) * cs;
#pragma unroll
    for (int p = 0; p < 8; ++p) { const int n = n0 + nl + 8 * p; int row = n;
      if (mode == 1) row = (n >> 7) * 256 + (n & 127); else if (mode == 2) row = (n >> 7) * 256 + 128 + (n & 127);
      dst[(size_t)row * ldd + k0 + kl] = f2bf(tile[kl * 65 + nl + 8 * p] * s); } }
}

__device__ void phase_prep(const Params& p, unsigned char* shm) {
  const int tid = otid(), G = ogrid(), bid = obid(), wid = tid >> 6, lane = tid & 63;
  float* ss = (float*)(p.ws + WS_SS);
  for (int i = bid * 512 + tid; i < 2 * NTOK; i += G * 512) ss[i] = 0.f;
  if (bid == 0) {
    float* consts = (float*)(p.ws + WS_CONST); float* tab = (float*)(p.ws + WS_TAB);
    if (tid == 0) { float a = 0.f, b = 0.f; for (int i = 0; i < 64; ++i) { a += p.lq1[i] * p.lk1[i]; b += p.lq2[i] * p.lk2[i]; } consts[0] = expf(a) - expf(b) + 0.2f; }
    for (int i = tid; i < 8 * 257; i += 512) { const int h = i / 257, j = i % 257, rel = j - 128, n = rel < 0 ? -rel : rel;
      int bk = n < 8 ? n : 8 + (n >= 12) + (n >= 16) + (n >= 23) + (n >= 32) + (n >= 46) + (n >= 64) + (n >= 91);
      if (rel > 0) bk += 16;
      tab[i] = p.relb[bk * 8 + h] * LOG2E; }
  }
  float* ct = (float*)shm;
  if (tid < 128) ct[tid] = cospif((float)tid * (1.f / 64.f));
  __syncthreads();
  float* AB = (float*)(p.ws + WS_AB);
  for (int i = bid * 512 + tid; i < 8 * 2 * 128 * 128; i += G * 512) {
    const int e = i & 127, c = (i >> 7) & 127, part = (i >> 14) & 1, g = i >> 15; float acc = 0.f;
    for (int m = 0; m < 128; ++m) { const int j = (c * m - part * 32) & 127; acc += ct[j] * p.w_f[(size_t)(g * 128 + m) * 128 + e]; }
    AB[i] = acc * 0.08838834764831845f;
  }
  __syncthreads();
  float* tile = (float*)shm;
  bf16_t* Win = (bf16_t*)(p.ws + WS_WIN); bf16_t* Wout = (bf16_t*)(p.ws + WS_WOUT); bf16_t* Wgu = (bf16_t*)(p.ws + WS_WGU); bf16_t* Wd = (bf16_t*)(p.ws + WS_WD);
  for (int t = bid; t < 11008; t += G) {
    if (t < 512)        { const int u = t;        tconv_tile(p.w_in + 1024, 4096, p.g1, 0.125f * LOG2E, Win + (size_t)2048 * DM, DM, 0, (u / 16) * 64, (u % 16) * 64, tile); }
    else if (t < 1536)  { const int u = t - 512;  tconv_tile(p.w_in + 2048, 4096, p.g1, 1.f, Win + (size_t)3072 * DM, DM, 0, (u / 32) * 64, (u % 32) * 64, tile); }
    else if (t < 2560)  { const int u = t - 1536; tconv_tile(p.w_out, 2048, nullptr, 1.f, Wout, DM, 0, (u / 32) * 64, (u % 32) * 64, tile); }
    else if (t < 5376)  { const int u = t - 2560; tconv_tile(p.w_gate, DFF, p.g2, 1.f, Wgu, DM, 1, (u / 88) * 64, (u % 88) * 64, tile); }
    else if (t < 8192)  { const int u = t - 5376; tconv_tile(p.w_up, DFF, p.g2, 1.f, Wgu, DM, 2, (u / 88) * 64, (u % 88) * 64, tile); }
    else                { const int u = t - 8192; tconv_tile(p.w_down, DM, nullptr, 1.f, Wd, DFF, 0, (u / 32) * 64, (u % 32) * 64, tile); }
  }
  bf16_t* xb = (bf16_t*)((unsigned char*)p.out + OUT_XB); float* rs1 = (float*)(p.ws + WS_RS1);
  for (int row = bid * 8 + wid; row < NTOK; row += G * 8) {
    const float* xr = row < TOKP ? p.xp + (size_t)row * DM : p.xs + (size_t)(row - TOKP) * DM; float sq = 0.f;
#pragma unroll
    for (int it = 0; it < 4; ++it) { const int c = it * 512 + lane * 8; const f32x4 a = *(const f32x4*)(xr + c), b = *(const f32x4*)(xr + c + 4);
      sq += a[0] * a[0] + a[1] * a[1] + a[2] * a[2] + a[3] * a[3] + b[0] * b[0] + b[1] * b[1] + b[2] * b[2] + b[3] * b[3];
      u32x4 w; w.x = cvt_pk_bf16(a[0], a[1]); w.y = cvt_pk_bf16(a[2], a[3]); w.z = cvt_pk_bf16(b[0], b[1]); w.w = cvt_pk_bf16(b[2], b[3]);
      *(u32x4*)(xb + (size_t)row * DM + c) = w; }
#pragma unroll
    for (int o = 32; o >= 1; o >>= 1) sq += __shfl_xor(sq, o);
    if (lane == 0) rs1[row] = rsqrtf(sq * (1.f / DM) + EPS);
  }
}

__device__ void phase_fold(const Params& p, unsigned char* shm) {
  const int tid = otid(), G = ogrid(), bid = obid();
  float* wt = (float*)shm;
  float* ab = (float*)(shm + 33280);
  const float* AB = (const float*)(p.ws + WS_AB); bf16_t* Win = (bf16_t*)(p.ws + WS_WIN);
  for (int it = bid; it < 512; it += G) {
    const int kb = it & 31, part = (it >> 5) & 1, g = it >> 6, k0 = kb * 64;
    __syncthreads();
    for (int i = tid; i < 64 * 128; i += 512) { const int kl = i >> 7, c = i & 127; wt[kl * 129 + c] = p.w_in[(size_t)(k0 + kl) * 4096 + g * 128 + c]; }
    for (int i = tid; i < 128 * 128; i += 512) ab[i] = AB[(size_t)((g * 2 + part) * 128) * 128 + i];
    __syncthreads();
    const int kl = tid & 63, eg = tid >> 6; float acc[16];
#pragma unroll
    for (int i = 0; i < 16; ++i) acc[i] = 0.f;
    for (int c = 0; c < 128; ++c) { const float w = wt[kl * 129 + c]; const float* ar = ab + c * 128 + eg * 16;
#pragma unroll
      for (int q = 0; q < 4; ++q) { const f32x4 a = *(const f32x4*)(ar + q * 4); acc[q * 4 + 0] += w * a[0]; acc[q * 4 + 1] += w * a[1]; acc[q * 4 + 2] += w * a[2]; acc[q * 4 + 3] += w * a[3]; } }
    const float s = p.g1[k0 + kl];
#pragma unroll
    for (int i = 0; i < 16; ++i) Win[(size_t)(part * 1024 + g * 128 + eg * 16 + i) * DM + k0 + kl] = f2bf(acc[i] * s);
  }
}

template <int KK, int NT> struct BTile {
  static constexpr int RS = NT * 2 + 16, CPR = NT / 8, RPP = 512 / CPR, NP = KK / RPP;
  bf16x8 v[NP];
  template <class RowPtr> __device__ __forceinline__ void gload(int tid, RowPtr rp) {
    const int c = tid % CPR, r0 = tid / CPR;
#pragma unroll
    for (int q = 0; q < NP; ++q) v[q] = *(const bf16x8*)(rp(r0 + q * RPP) + c * 8);
  }
  __device__ __forceinline__ void lstore(int tid, unsigned char* tile) const {
    const int c = tid % CPR, r0 = tid / CPR;
#pragma unroll
    for (int q = 0; q < NP; ++q) *(bf16x8*)(tile + (r0 + q * RPP) * RS + c * 16) = v[q];
  }
  static __device__ __forceinline__ int rd_base(unsigned char* tile, int lane) { const int g = lane >> 4, q = (lane & 15) >> 2, pp = lane & 3; return (int)(uintptr_t)tile + (8 * g + q) * RS + 8 * pp; }
};
template <int OFF> __device__ __forceinline__ s16x4 tr_rd(int vb) {
  s16x4 r; asm volatile("ds_read_b64_tr_b16 %0, %1 offset:%2" : "=&v"(r) : "v"(vb), "i"(OFF) : "memory"); return r;
}
#define TRFRAG(DST, vb, OFF, RS_) do { const int _a = (vb) + (OFF); const s16x4 _l = tr_rd<0>(_a), _h = tr_rd<4 * (RS_)>(_a); asm volatile("s_waitcnt lgkmcnt(0)" ::: "memory"); \
    DST = (bf16x8){_l[0], _l[1], _l[2], _l[3], _h[0], _h[1], _h[2], _h[3]}; } while (0)

template <int NB> struct S1Loop;
__device__ void fourier_stage1(const bf16_t* proj, bf16_t* Tb, unsigned char* shm) {
  constexpr int KK = 256, NT = 128;
  using BT = BTile<KK, NT>; constexpr int RS = BT::RS;
  const int tid = otid(), wid = tid >> 6, lane = tid & 63, fr = lane & 15, fq = lane >> 4, G = ogrid(), bid = obid();
  const int k1 = wid * 16 + fr;
  bf16x8 ar[8], ai[8];
#pragma unroll
  for (int ks = 0; ks < 8; ++ks)
#pragma unroll
    for (int e = 0; e < 8; e += 2) { float vr[2], vi[2];
#pragma unroll
      for (int d = 0; d < 2; ++d) { const int kk = ks * 32 + fq * 8 + e + d, pin = kk >> 7, s1 = kk & 127, j = (s1 * k1) & 127;
        const float cc = cospif((float)j * (1.f / 64.f)), sn = sinpif((float)j * (1.f / 64.f));
        vr[d] = pin ? -sn : cc; vi[d] = pin ? -cc : -sn; }
      const unsigned wr_ = cvt_pk_bf16(vr[0], vr[1]), wi_ = cvt_pk_bf16(vi[0], vi[1]);
      ar[ks][e] = (short)(wr_ & 0xffff); ar[ks][e + 1] = (short)(wr_ >> 16); ai[ks][e] = (short)(wi_ & 0xffff); ai[ks][e + 1] = (short)(wi_ >> 16); }
  const int vb = BT::rd_base(shm, lane);
  BT bt;
#define S1_DECODE(it) int tb, N2, S, s2, ct; if ((it) < 2048) { const int b = (it) >> 10; s2 = ((it) >> 3) & 127; ct = (it) & 7; tb = TOKP + b * SS; N2 = 128; S = SS; } \
    else { const int u = (it) - 2048, b = u >> 7; s2 = (u >> 3) & 15; ct = u & 7; tb = b * SP; N2 = 16; S = SP; } const int col0 = ct * NT; (void)S;
  if (bid < 4096) { S1_DECODE(bid); bt.gload(tid, [&](int r) { const int pin = r >> 7, s1 = r & 127; return proj + (size_t)(tb + N2 * s1 + s2) * PW + pin * 1024 + col0; }); }
  for (int it = bid; it < 4096; it += G) {
    S1_DECODE(it);
    __syncthreads();
    bt.lstore(tid, shm);
    __syncthreads();
    if (it + G < 4096) { const int itn = it + G; int tbn, N2n, s2n, ctn;
      if (itn < 2048) { const int b = itn >> 10; s2n = (itn >> 3) & 127; ctn = itn & 7; tbn = TOKP + b * SS; N2n = 128; }
      else { const int u = itn - 2048, b = u >> 7; s2n = (u >> 3) & 15; ctn = u & 7; tbn = b * SP; N2n = 16; }
      bt.gload(tid, [&](int r) { const int pin = r >> 7, s1 = r & 127; return proj + (size_t)(tbn + N2n * s1 + s2n) * PW + pin * 1024 + ctn * NT; }); }
    int vbi = vb; asm volatile("" : "+v"(vbi));
    const int jj = (s2 * k1) & (S - 1); const float ang = (float)jj * (2.f / (float)S); const float cw = cospif(ang), sw = sinpif(ang), sc = 0.08838834764831845f;
    unsigned char* stg = shm + 69632 + wid * 8704;
#pragma unroll
    for (int nb = 0; nb < NT / 16; ++nb) {
      f32x4 tr = {0.f, 0.f, 0.f, 0.f}, ti = {0.f, 0.f, 0.f, 0.f};
      s16x4 fl[8], fh[8];
#pragma unroll
      for (int ks = 0; ks < 8; ++ks) { const int a_ = vbi + ks * 32 * RS + nb * 32; fl[ks] = tr_rd<0>(a_); fh[ks] = tr_rd<4 * RS>(a_); }
      asm volatile("s_waitcnt lgkmcnt(0)" ::: "memory"); __builtin_amdgcn_sched_barrier(0);
#pragma unroll
      for (int ks = 0; ks < 8; ++ks) { const bf16x8 b = (bf16x8){fl[ks][0], fl[ks][1], fl[ks][2], fl[ks][3], fh[ks][0], fh[ks][1], fh[ks][2], fh[ks][3]};
        tr = __builtin_amdgcn_mfma_f32_16x16x32_bf16(b, ar[ks], tr, 0, 0, 0); ti = __builtin_amdgcn_mfma_f32_16x16x32_bf16(b, ai[ks], ti, 0, 0, 0); }
      float xr[4], xi[4];
#pragma unroll
      for (int j = 0; j < 4; ++j) { xr[j] = (tr[j] * cw + ti[j] * sw) * sc; xi[j] = (ti[j] * cw - tr[j] * sw) * sc; }
      u32x2 w0, w1; w0.x = cvt_pk_bf16(xr[0], xr[1]); w0.y = cvt_pk_bf16(xr[2], xr[3]); w1.x = cvt_pk_bf16(xi[0], xi[1]); w1.y = cvt_pk_bf16(xi[2], xi[3]);
      *(u32x2*)(stg + fr * 272 + (nb * 16 + fq * 4) * 2) = w0; *(u32x2*)(stg + 4352 + fr * 272 + (nb * 16 + fq * 4) * 2) = w1;
    }
    { bf16_t* ob = Tb + (size_t)tb * 2048 + (size_t)s2 * 128 * 1024 + (size_t)(wid * 16) * 1024 + col0;
#pragma unroll
      for (int q = 0; q < 8; ++q) { const int idx = q * 64 + lane, part = idx >> 8, row = (idx >> 4) & 15, ch = idx & 15;
        const u32x4 v = *(const u32x4*)(stg + part * 4352 + row * 272 + ch * 16);
        *(u32x4*)(ob + (size_t)part * N2 * 128 * 1024 + row * 1024 + ch * 8) = v; } }
  }
#undef S1_DECODE
}

template <int N2, int NT>
__device__ void fourier_stage2(const bf16_t* Tb, bf16_t* mix, int tb0, int nbatch, unsigned char* shm) {
  constexpr int KK = 2 * N2, KST = KK / 32, MB = N2 / 16, NWN = 8 / MB, S = 128 * N2, CT = 1024 / NT, NBW = (NT / 16) / NWN;
  using BT = BTile<KK, NT>; constexpr int RS = BT::RS;
  const int tid = otid(), wid = tid >> 6, lane = tid & 63, fr = lane & 15, fq = lane >> 4, G = ogrid(), bid = obid();
  const int mb = wid % MB, wn = wid / MB, k2 = mb * 16 + fr;
  bf16x8 af[KST];
#pragma unroll
  for (int ks = 0; ks < KST; ++ks)
#pragma unroll
    for (int e = 0; e < 8; e += 2) { float v[2];
#pragma unroll
      for (int d = 0; d < 2; ++d) { const int kk = ks * 32 + fq * 8 + e + d, part = kk / N2, s2 = kk % N2, j = (s2 * k2) % N2; const float a = (float)j * (2.f / (float)N2);
        v[d] = part ? sinpif(a) : cospif(a); }
      const unsigned w = cvt_pk_bf16(v[0], v[1]); af[ks][e] = (short)(w & 0xffff); af[ks][e + 1] = (short)(w >> 16); }
  const float sc = rsqrtf((float)N2);
  const int nitems = nbatch * 128 * CT;
  const int vb = BT::rd_base(shm, lane) + wn * NBW * 32;
  BT bt;
  auto rowp = [&](int it, int r) { const int ct = it % CT, k1 = (it / CT) & 127, b = it / (CT * 128), tb = tb0 + b * S; const int part = r / N2, s2 = r % N2;
    return Tb + (size_t)tb * 2048 + ((size_t)(part * N2 + s2) * 128 + k1) * 1024 + ct * NT; };
  if (bid < nitems) bt.gload(tid, [&](int r) { return rowp(bid, r); });
  for (int it = bid; it < nitems; it += G) {
    const int ct = it % CT, k1 = (it / CT) & 127, b = it / (CT * 128), tb = tb0 + b * S, col0 = ct * NT;
    __syncthreads();
    bt.lstore(tid, shm);
    __syncthreads();
    if (it + G < nitems) { const int itn = it + G; bt.gload(tid, [&](int r) { return rowp(itn, r); }); }
    int vbi = vb; asm volatile("" : "+v"(vbi));
    unsigned char* stg = shm + 69632 + wid * 4352;
#pragma unroll
    for (int i = 0; i < NBW; ++i) {
      f32x4 y = {0.f, 0.f, 0.f, 0.f};
      s16x4 fl[KST], fh[KST];
#pragma unroll
      for (int ks = 0; ks < KST; ++ks) { const int a_ = vbi + ks * 32 * RS + i * 32; fl[ks] = tr_rd<0>(a_); fh[ks] = tr_rd<4 * RS>(a_); }
      asm volatile("s_waitcnt lgkmcnt(0)" ::: "memory"); __builtin_amdgcn_sched_barrier(0);
#pragma unroll
      for (int ks = 0; ks < KST; ++ks) { const bf16x8 bb = (bf16x8){fl[ks][0], fl[ks][1], fl[ks][2], fl[ks][3], fh[ks][0], fh[ks][1], fh[ks][2], fh[ks][3]};
        y = __builtin_amdgcn_mfma_f32_16x16x32_bf16(bb, af[ks], y, 0, 0, 0); }
      u32x2 w; w.x = cvt_pk_bf16(y[0] * sc, y[1] * sc); w.y = cvt_pk_bf16(y[2] * sc, y[3] * sc);
      *(u32x2*)(stg + fr * 272 + (i * 16 + fq * 4) * 2) = w;
    }
    { bf16_t* ob = mix + (size_t)(tb + k1 + 128 * (mb * 16)) * DM + col0 + wn * NBW * 16;
#pragma unroll
      for (int q = 0; q < 4; ++q) { const int idx = q * 64 + lane, row = idx >> 4, ch = idx & 15;
        const u32x4 v = *(const u32x4*)(stg + row * 272 + ch * 16);
        *(u32x4*)(ob + (size_t)(128 * row) * DM + ch * 8) = v; } }
  }
}

namespace at {
constexpr int KVBLK = 64, LD = PW;
constexpr size_t SHM_V = KVBLK * 128 * 2, SHM_K = KVBLK * 128 * 2;
#define KSWZ(row, colB) ((row) * 256 + ((colB) ^ (((row) & 7) << 4)))
#define SBAR() __builtin_amdgcn_sched_barrier(0)
__device__ __forceinline__ int crow(int r, int hi) { return (r & 3) + 8 * (r >> 2) + 4 * hi; }
__device__ __forceinline__ void tileBias(f32x16& p0, f32x16& p1, const float* tabl) {
#pragma unroll
  for (int r = 0; r < 16; ++r) p0[r] += tabl[(r & 3) + 8 * (r >> 2)];
  SBAR();
#pragma unroll
  for (int r = 0; r < 16; ++r) p1[r] += tabl[32 + (r & 3) + 8 * (r >> 2)];
  SBAR();
}
__device__ __forceinline__ void expHalf(f32x16& p) {
#pragma unroll
  for (int r = 0; r < 16; ++r) p[r] = __builtin_amdgcn_exp2f(p[r]);
}
__device__ __forceinline__ void firstSM(f32x16& p0, f32x16& p1, float& M, bool nearT, float bconst, const float* tabl) {
  if (nearT) tileBias(p0, p1, tabl);
  float pmax = p0[0];
#pragma unroll
  for (int r = 1; r < 16; ++r) pmax = fmaxf(pmax, p0[r]);
#pragma unroll
  for (int r = 0; r < 16; ++r) pmax = fmaxf(pmax, p1[r]);
  { auto rr = __builtin_amdgcn_permlane32_swap(__float_as_uint(pmax), __float_as_uint(pmax), false, false);
    pmax = fmaxf(__uint_as_float(rr[0]), __uint_as_float(rr[1])); }
  M = pmax + bconst;
  const float off = bconst - M;
#pragma unroll
  for (int r = 0; r < 16; ++r) p0[r] += off;
#pragma unroll
  for (int r = 0; r < 16; ++r) p1[r] += off;
  expHalf(p0); expHalf(p1);
}
__device__ __forceinline__ void finishSM(f32x16& p0, f32x16& p1, float& l_reg, bf16x8& pa0, bf16x8& pa1, bf16x8& pa2, bf16x8& pa3) {
  float ps = 0;
#pragma unroll
  for (int r = 0; r < 16; ++r) ps += p0[r];
#pragma unroll
  for (int r = 0; r < 16; ++r) ps += p1[r];
  { auto rr = __builtin_amdgcn_permlane32_swap(__float_as_uint(ps), __float_as_uint(ps), false, false);
    ps = __uint_as_float(rr[0]) + __uint_as_float(rr[1]); }
  l_reg += ps;
#define PK4(P, BASE, OUT) do { unsigned a0 = cvt_pk_bf16(P[BASE + 0], P[BASE + 1]), a1 = cvt_pk_bf16(P[BASE + 2], P[BASE + 3]);   \
    unsigned b0 = cvt_pk_bf16(P[BASE + 4], P[BASE + 5]), b1 = cvt_pk_bf16(P[BASE + 6], P[BASE + 7]);                              \
    u32x4 w = {a0, a1, b0, b1}; OUT = *reinterpret_cast<bf16x8*>(&w); } while (0)
  PK4(p0, 0, pa0); PK4(p0, 8, pa1); PK4(p1, 0, pa2); PK4(p1, 8, pa3);
#undef PK4
}
__device__ __forceinline__ void qkt(f32x16& p0, f32x16& p1, const bf16_t* Ks, const bf16x8* qr, bf16x8 onesf, bf16x8 qext, int r32, int hi, int c) {
  const f32x16 z = {};
  p0 = __builtin_amdgcn_mfma_f32_32x32x16_bf16(onesf, qext, z, 0, 0, 0);
  p1 = __builtin_amdgcn_mfma_f32_32x32x16_bf16(onesf, qext, z, 0, 0, 0);
  const char* Kc = (const char*)Ks + c * 128;
#pragma unroll
  for (int d0 = 0; d0 < 4; ++d0) { const int cb = (d0 * 16 + hi * 8) * 2;
    bf16x8 b0 = *reinterpret_cast<const bf16x8*>(Kc + KSWZ(r32, cb));
    bf16x8 b1 = *reinterpret_cast<const bf16x8*>(Kc + KSWZ(32 + r32, cb));
    p0 = __builtin_amdgcn_mfma_f32_32x32x16_bf16(b0, qr[d0], p0, 0, 0, 0);
    p1 = __builtin_amdgcn_mfma_f32_32x32x16_bf16(b1, qr[d0], p1, 0, 0, 0); }
}
__device__ __forceinline__ int v_st(int k, int c) { const int kk = k; return ((kk >> 3) * 4 + (c >> 5)) * 512 + ((kk & 7) * 32 + (c & 31)) * 2; }
__device__ __forceinline__ int v_rd_base(int lane) { return ((lane & 3) << 3) | (((lane >> 2) & 3) << 6) | (((lane >> 4) & 1) << 5) | (((lane >> 5) & 1) << 8); }
constexpr int v_rd_off(int d0, int ks, int half) { return d0 * 512 + ks * 4096 + half * 2048; }
template <int OFF> __device__ __forceinline__ s16x4 tr_read(int vb) {
  s16x4 r; asm volatile("ds_read_b64_tr_b16 %0, %1 offset:%2" : "=&v"(r) : "v"(vb), "i"(OFF) : "memory"); return r;
}
template <int D0, bool EXP> __device__ __forceinline__ void pv_one(f32x16& od, int vb, bf16x8 pa0, bf16x8 pa1, bf16x8 pa2, bf16x8 pa3, f32x16& pe, f32x16& pf) {
  const s16x4 l0 = tr_read<v_rd_off(D0, 0, 0)>(vb), h0 = tr_read<v_rd_off(D0, 0, 1)>(vb), l1 = tr_read<v_rd_off(D0, 1, 0)>(vb), h1 = tr_read<v_rd_off(D0, 1, 1)>(vb);
  const s16x4 l2 = tr_read<v_rd_off(D0, 2, 0)>(vb), h2 = tr_read<v_rd_off(D0, 2, 1)>(vb), l3 = tr_read<v_rd_off(D0, 3, 0)>(vb), h3 = tr_read<v_rd_off(D0, 3, 1)>(vb);
  asm volatile("s_waitcnt lgkmcnt(0)" ::: "memory"); SBAR();
#define PK(L, H) (bf16x8){L[0], L[1], L[2], L[3], H[0], H[1], H[2], H[3]}
  od = __builtin_amdgcn_mfma_f32_32x32x16_bf16(pa0, PK(l0, h0), od, 0, 0, 0);
  if (EXP) { pe[4 * D0 + 0] = __builtin_amdgcn_exp2f(pe[4 * D0 + 0]); pf[4 * D0 + 0] = __builtin_amdgcn_exp2f(pf[4 * D0 + 0]); }
  od = __builtin_amdgcn_mfma_f32_32x32x16_bf16(pa1, PK(l1, h1), od, 0, 0, 0);
  if (EXP) { pe[4 * D0 + 1] = __builtin_amdgcn_exp2f(pe[4 * D0 + 1]); pf[4 * D0 + 1] = __builtin_amdgcn_exp2f(pf[4 * D0 + 1]); }
  od = __builtin_amdgcn_mfma_f32_32x32x16_bf16(pa2, PK(l2, h2), od, 0, 0, 0);
  if (EXP) { pe[4 * D0 + 2] = __builtin_amdgcn_exp2f(pe[4 * D0 + 2]); pf[4 * D0 + 2] = __builtin_amdgcn_exp2f(pf[4 * D0 + 2]); }
  od = __builtin_amdgcn_mfma_f32_32x32x16_bf16(pa3, PK(l3, h3), od, 0, 0, 0);
  if (EXP) { pe[4 * D0 + 3] = __builtin_amdgcn_exp2f(pe[4 * D0 + 3]); pf[4 * D0 + 3] = __builtin_amdgcn_exp2f(pf[4 * D0 + 3]); }
#undef PK
}
template <bool EXP> __device__ __forceinline__ void pv_d0(f32x16* o, int vb, bf16x8 pa0, bf16x8 pa1, bf16x8 pa2, bf16x8 pa3, f32x16& pe, f32x16& pf) {
  pv_one<0, EXP>(o[0], vb, pa0, pa1, pa2, pa3, pe, pf); pv_one<1, EXP>(o[1], vb, pa0, pa1, pa2, pa3, pe, pf); pv_one<2, EXP>(o[2], vb, pa0, pa1, pa2, pa3, pe, pf); pv_one<3, EXP>(o[3], vb, pa0, pa1, pa2, pa3, pe, pf);
}

__device__ __forceinline__ void attn_pass(const bf16_t* Qb, const bf16_t* Kh, const bf16_t* Vh, int seq, int q0, int c, char* lds, const float* tab, f32x16 (&o)[4], float& l_out) {
  const int tid = otid(), wid = tid >> 6, lane = tid & 63, r32 = lane & 31, hi = lane >> 5;
  bf16_t* V_lds = (bf16_t*)lds; bf16_t* K_lds = (bf16_t*)(lds + 2 * SHM_V);
  float l_reg = 0, Mrow = 0.f;
#pragma unroll
  for (int d = 0; d < 4; ++d) o[d] = f32x16{};
  bf16x8 qr[4];
  const bf16_t* Qw = Qb + (size_t)(wid * 32 + r32) * LD + hi * 8;
#pragma unroll
  for (int d0 = 0; d0 < 4; ++d0) qr[d0] = *reinterpret_cast<const bf16x8*>(Qw + d0 * 16);
  const int sr = tid >> 4, sc = (tid & 15) * 8, vst0 = v_st(sr, sc), vst1 = v_st(32 + sr, sc);
  const int vb0 = (int)(uintptr_t)V_lds + v_rd_base(lane);
  const int qw0 = q0 + wid * 32, qrow = qw0 + r32;
  struct { bf16x8 vs0, vs1, ks0, ks1; } sr_[1];
#define SLOAD(i, k0) do { sr_[i].vs0 = *(const bf16x8*)(&Vh[(size_t)((k0) + sr) * LD + sc]); sr_[i].vs1 = *(const bf16x8*)(&Vh[(size_t)((k0) + 32 + sr) * LD + sc]); \
    sr_[i].ks0 = *(const bf16x8*)(&Kh[(size_t)((k0) + sr) * LD + sc]); sr_[i].ks1 = *(const bf16x8*)(&Kh[(size_t)((k0) + 32 + sr) * LD + sc]); } while (0)
#define SWRITE(b, i) do { *(bf16x8*)((char*)V_lds + (b) * SHM_V + vst0) = sr_[i].vs0;          \
    *(bf16x8*)((char*)V_lds + (b) * SHM_V + vst1) = sr_[i].vs1; int kc = sc * 2;               \
    *(bf16x8*)((char*)K_lds + (b) * SHM_K + KSWZ(sr, kc)) = sr_[i].ks0;                       \
    *(bf16x8*)((char*)K_lds + (b) * SHM_K + KSWZ(32 + sr, kc)) = sr_[i].ks1; } while (0)
#define SWAIT() asm volatile("s_waitcnt vmcnt(0)" ::: "memory")
  float bneg = 0.f, bpos = 0.f;
  unsigned wneg = 0u, wnear = 0u, wpos = 0u;
  bf16x8 onesf;
  { const u32x4 w = {hi == 0 ? 0x3f803f80u : 0u, 0u, 0u, 0u}; onesf = *reinterpret_cast<const bf16x8*>(&w); }
  u32x4 qw4 = {0u, 0u, 0u, 0u};
#define QEXT() (*reinterpret_cast<const bf16x8*>(&qw4))
#define NEARQ(t) (((t) * KVBLK + 63 - qw0 > -128) && ((t) * KVBLK - (qw0 + 31) < 128))
#define BCONST(t) (NEARQ(t) ? 0.f : ((t) * KVBLK > qw0 ? bpos : bneg))
#define MKW(bc) ([&]() -> unsigned { const float _off = (bc) - Mrow; const float _oh = __uint_as_float((cvt_pk_bf16(_off, 0.f) & 0xffffu) << 16); return hi == 0 ? cvt_pk_bf16(_off, _off - _oh) : 0u; }())
#define PREP(t) do { qw4.x = NEARQ(t) ? wnear : ((t) * KVBLK > qw0 ? wpos : wneg); } while (0)
#define PSB(P0, P1, t) do { if (NEARQ(t)) tileBias(P0, P1, tab + ((t) * KVBLK - qrow + 224 + 4 * hi)); } while (0)
  f32x16 pA0, pA1, pB0, pB1; bf16x8 pa0, pa1, pa2, pa3; const int NT = seq / KVBLK;
  constexpr int SE = 0, SO = 0;
  SLOAD(SE, 0); asm volatile("s_waitcnt vmcnt(0)" ::: "memory"); SWRITE(0, SE); __syncthreads();
  bneg = __uint_as_float(__builtin_amdgcn_readfirstlane(__float_as_uint(tab[0]))); bpos = __uint_as_float(__builtin_amdgcn_readfirstlane(__float_as_uint(tab[448])));
  qkt(pA0, pA1, K_lds, qr, onesf, QEXT(), r32, hi, c);
  firstSM(pA0, pA1, Mrow, NEARQ(0), BCONST(0), tab + (0 - qrow + 224 + 4 * hi));
  wneg = MKW(bneg); wnear = MKW(0.f); wpos = MKW(bpos);
  SLOAD(SO, KVBLK);
  SWAIT(); SWRITE(1, SO); __syncthreads();
  for (int j = 1; j + 1 < NT; j += 2) {
    SBAR(); PREP(j); qkt(pB0, pB1, (bf16_t*)((char*)K_lds + SHM_K), qr, onesf, QEXT(), r32, hi, c);
    finishSM(pA0, pA1, l_reg, pa0, pa1, pa2, pa3); SBAR();
    SLOAD(SO, (j + 1) * KVBLK); SBAR();
    PSB(pB0, pB1, j); pv_d0<true>(o, vb0, pa0, pa1, pa2, pa3, pB0, pB1);
    __syncthreads(); SWAIT(); SWRITE(0, SE);
    __syncthreads();
    SBAR(); PREP(j + 1); qkt(pA0, pA1, K_lds, qr, onesf, QEXT(), r32, hi, c);
    finishSM(pB0, pB1, l_reg, pa0, pa1, pa2, pa3); SBAR();
    SLOAD(SE, (j + 2) * KVBLK); SBAR();
    PSB(pA0, pA1, j + 1); pv_d0<true>(o, vb0 + (int)SHM_V, pa0, pa1, pa2, pa3, pA0, pA1);
    __syncthreads(); SWAIT(); SWRITE(1, SO);
    __syncthreads();
  }
  SBAR(); PREP(NT - 1); qkt(pB0, pB1, (bf16_t*)((char*)K_lds + SHM_K), qr, onesf, QEXT(), r32, hi, c);
  finishSM(pA0, pA1, l_reg, pa0, pa1, pa2, pa3); SBAR();
  PSB(pB0, pB1, NT - 1); pv_d0<true>(o, vb0, pa0, pa1, pa2, pa3, pB0, pB1);
  __syncthreads();
  finishSM(pB0, pB1, l_reg, pa0, pa1, pa2, pa3); SBAR();
  pv_d0<false>(o, vb0 + (int)SHM_V, pa0, pa1, pa2, pa3, pB0, pB1);
  l_out = l_reg;
#undef SLOAD
#undef SWRITE
#undef SWAIT
#undef PSB
#undef PREP
#undef MKW
#undef QEXT
#undef BCONST
#undef NEARQ
}
}

__device__ void phase_attn(const Params& p, unsigned char* shm) {
  using namespace at;
  const int tid = otid(), wid = tid >> 6, lane = tid & 63, r32 = lane & 31, hi = lane >> 5, G = ogrid(), bid = obid();
  char* lds = (char*)shm;
  float* wsl = (float*)(lds + 2 * SHM_V + 2 * SHM_K) + wid * 64; float* li_l = wsl;
  float* tab = (float*)(lds + 2 * SHM_V + 2 * SHM_K + 8 * 64 * 4);
  const bf16_t* proj = (const bf16_t*)(p.ws + WS_PROJ); bf16_t* mix = (bf16_t*)(p.ws + WS_MIX);
  float* stash = (float*)((unsigned char*)p.out + OUT_STASH) + (size_t)bid * (64 * 512);
  const float* tabg = (const float*)(p.ws + WS_TAB);
  const float lam = ((const float*)(p.ws + WS_CONST))[0];
  unsigned* qctr = (unsigned*)(p.ws + WS_QCTR); volatile unsigned* nextw = (volatile unsigned*)(shm + LDS_BYTES - 32);
  int it = bid;
  while (it < 2048) {
    int tb, S, h, qb;
    if (it < 1024) { const int b = it >> 9; h = (it >> 6) & 7; qb = it & 63; tb = TOKP + b * SS; S = SS; }
    else { const int u = it - 1024, b = u >> 6; h = (u >> 3) & 7; qb = u & 7; tb = b * SP; S = SP; }
    const int q0 = qb * 256;
    __syncthreads();
    if (tid < 449) { int j = tid - 96; j = j < 0 ? 0 : (j > 256 ? 256 : j); tab[tid] = tabg[h * 257 + j]; }
    const bf16_t* Kh = proj + (size_t)tb * PW + 3072 + h * 128; const bf16_t* Vh = proj + (size_t)tb * PW + 4096 + h * 128;
    const bf16_t* Qb = proj + (size_t)(tb + q0) * PW + 2048 + h * 128;
    f32x16 o[4]; float l_reg;
#pragma nounroll
    for (int c = 0; c < 2; ++c) {
      attn_pass(Qb + c * 64, Kh, Vh, S, q0, c, lds, tab, o, l_reg);
      int hi_e = hi, r32_e = r32; asm volatile("" : "+v"(hi_e), "+v"(r32_e));
      if (hi == 0) li_l[r32] = l_reg; asm volatile("s_waitcnt lgkmcnt(0)" ::: "memory");
      const float* li_h = li_l + 4 * hi_e;
      if (c == 0) {
#pragma unroll
        for (int r = 0; r < 16; ++r) { const float rl = __builtin_amdgcn_rcpf(li_h[crow(r, 0)]);
          *(f32x4*)(stash + tid * 64 + r * 4) = (f32x4){o[0][r] * rl, o[1][r] * rl, o[2][r] * rl, o[3][r] * rl}; }
      } else {
        float sg[4];
#pragma unroll
        for (int d0 = 0; d0 < 4; ++d0) sg[d0] = p.subg[d0 * 32 + r32_e] * 0.8f;
        bf16_t* ob = mix + (size_t)(tb + q0 + wid * 32 + 4 * hi_e) * DM + 1024 + h * 128 + r32_e;
#pragma unroll
        for (int r = 0; r < 16; ++r) { const float rl = __builtin_amdgcn_rcpf(li_h[crow(r, 0)]) * lam; float v[4]; float sq = 0.f;
          const f32x4 st = *(const f32x4*)(stash + tid * 64 + r * 4);
#pragma unroll
          for (int d0 = 0; d0 < 4; ++d0) { v[d0] = st[d0] - o[d0][r] * rl; sq += v[d0] * v[d0]; }
          sq += __shfl_xor(sq, 1); sq += __shfl_xor(sq, 2); sq += __shfl_xor(sq, 4); sq += __shfl_xor(sq, 8); sq += __shfl_xor(sq, 16);
          const float rn = rsqrtf(sq * (1.f / 128.f) + EPS);
#pragma unroll
          for (int d0 = 0; d0 < 4; ++d0) ob[(size_t)crow(r, 0) * DM + d0 * 32] = f2bf(v[d0] * rn * sg[d0]); }
      }
    }
    __syncthreads();
    if (tid == 0) nextw[0] = (unsigned)G + atomicAdd(qctr, 1u);
    __syncthreads();
    it = __builtin_amdgcn_readfirstlane((int)nextw[0]);
  }
}

__device__ void phase_final(const Params& p) {
  const int tid = otid(), G = ogrid(), bid = obid(), wid = tid >> 6, lane = tid & 63;
  const float* ss3 = (const float*)(p.ws + WS_SS) + NTOK; const bf16_t* x2 = (const bf16_t*)(p.ws + WS_X1B);
  for (int row = bid * 8 + wid; row < NTOK; row += G * 8) {
    const float r = rsqrtf(ss3[row] * (1.f / DM) + EPS); const bf16_t* xr = x2 + (size_t)row * DM; float* orow = p.out + (size_t)row * DM;
#pragma unroll
    for (int it = 0; it < 4; ++it) { const int c = it * 512 + lane * 8; const u32x4 w = *(const u32x4*)(xr + c);
      const f32x4 g0 = *(const f32x4*)(p.fg + c), g1 = *(const f32x4*)(p.fg + c + 4);
      const f32x4 a = {__uint_as_float(w.x << 16), __uint_as_float(w.x & 0xffff0000u), __uint_as_float(w.y << 16), __uint_as_float(w.y & 0xffff0000u)};
      const f32x4 b = {__uint_as_float(w.z << 16), __uint_as_float(w.z & 0xffff0000u), __uint_as_float(w.w << 16), __uint_as_float(w.w & 0xffff0000u)};
      *(f32x4*)(orow + c) = a * r * g0; *(f32x4*)(orow + c + 4) = b * r * g1; }
  }
}

#define XB_TMO      128
#define XB_XCNT(j)  (256  + 64 * (j))
#define XB_XSUB(j)  (1280 + 64 * (j))
#define XB_XGEN(j)  (2304 + 64 * (j))
#define XB_TOP      3328
#define XB_TOPGEN   3392
#define XCD_BAR_WORDS 3456
#define XB_SPIN_CAP (1u << 18)
__device__ __forceinline__ unsigned xb_ld(unsigned* p)              { return __hip_atomic_load(p, __ATOMIC_RELAXED, __HIP_MEMORY_SCOPE_AGENT); }
__device__ __forceinline__ unsigned xb_add(unsigned* p, unsigned v) { return __hip_atomic_fetch_add(p, v, __ATOMIC_RELAXED, __HIP_MEMORY_SCOPE_AGENT); }
__device__ __forceinline__ unsigned xb_xcc_id() { return (unsigned)__builtin_amdgcn_s_getreg((3 << 11) | 20) & 0xFu; }
#define XB_SPIN(cond, bar) do { unsigned _sp = 0; while (cond) { __builtin_amdgcn_s_sleep(1); \
    if ((++_sp & 255u) == 0u) { if (xb_ld(&(bar)[XB_TMO])) break; if (_sp > XB_SPIN_CAP) { atomicAdd(&(bar)[XB_TMO], 1u); break; } } } } while (0)
struct XcdBarrier { unsigned* bar; unsigned x; volatile LAS unsigned* st; };
__device__ __forceinline__ XcdBarrier xcd_barrier_post(unsigned* bar, volatile LAS unsigned* st) {
  XcdBarrier b; b.bar = bar; b.x = xb_xcc_id(); b.st = st;
  if (threadIdx.x == 0) (void)xb_add(&bar[XB_XCNT(b.x)], 1u);
  return b;
}
__device__ __forceinline__ void xcd_barrier_complete(unsigned* bar, unsigned x, unsigned& nloc, unsigned& nx) {
  const unsigned G = gridDim.x * gridDim.y * gridDim.z;
  unsigned sum, cnt, mine, sp = 0u;
  for (;;) {
    sum = 0u; cnt = 0u; mine = 0u;
#pragma unroll
    for (unsigned j = 0; j < 16; ++j) { const unsigned c = xb_ld(&bar[XB_XCNT(j)]); sum += c; cnt += (c > 0u) ? 1u : 0u; mine = (j == x) ? c : mine; }
    if (sum == G) break;
    __builtin_amdgcn_s_sleep(1);
    if ((++sp & 255u) == 0u) { if (xb_ld(&bar[XB_TMO])) break; if (sp > XB_SPIN_CAP) { atomicAdd(&bar[XB_TMO], 1u); break; } }
  }
  nloc = mine > 0u ? mine : 1u; nx = cnt > 0u ? cnt : 1u;
}
__device__ __forceinline__ void xcd_barrier(const XcdBarrier& b) {
  asm volatile("s_waitcnt vmcnt(0)" ::: "memory");
  __syncthreads();
  if (threadIdx.x == 0) {
    unsigned* bar = b.bar;
    __builtin_amdgcn_s_waitcnt(0);
    unsigned nloc = b.st[0], nx = b.st[1];
    if (nloc == 0u) { xcd_barrier_complete(bar, b.x, nloc, nx); b.st[0] = nloc; b.st[1] = nx; }
    const unsigned old = xb_add(&bar[XB_XSUB(b.x)], 1u);
    const unsigned gen = old / nloc;
    if (old + 1u == (gen + 1u) * nloc) {
      __builtin_amdgcn_fence(__ATOMIC_RELEASE, "agent");
      asm volatile("s_waitcnt vmcnt(0)" ::: "memory");
      const unsigned og = xb_add(&bar[XB_TOP], 1u);
      const unsigned tg = og / nx;
      if (og + 1u == (tg + 1u) * nx) xb_add(&bar[XB_TOPGEN], 1u);
      else XB_SPIN(xb_ld(&bar[XB_TOPGEN]) == tg, bar);
      __builtin_amdgcn_fence(__ATOMIC_ACQUIRE, "agent");
      xb_add(&bar[XB_XGEN(b.x)], 1u);
      asm volatile("s_waitcnt vmcnt(0)" ::: "memory");
    } else {
      XB_SPIN(xb_ld(&bar[XB_XGEN(b.x)]) == gen, bar);
      __builtin_amdgcn_fence(__ATOMIC_ACQUIRE, "agent");
      asm volatile("s_waitcnt vmcnt(0)" ::: "memory");
    }
  }
  __syncthreads();
}

constexpr int NPHASE = 11;
__global__ __launch_bounds__(512, 2) void mega(Params p) {
  extern __shared__ __attribute__((aligned(16))) unsigned char shm[];
  unsigned char* ws = p.ws;
#define PHASE(ph) if (p.ph_lo <= (ph) && (ph) < p.ph_hi)
  XcdBarrier xbar; xbar.bar = (unsigned*)(ws + WS_BAR); xbar.x = 0; xbar.st = (volatile LAS unsigned*)(shm + LDS_BYTES - 16);
  if (p.ph_hi - p.ph_lo > 2) { if (threadIdx.x == 0) { xbar.st[0] = 0u; xbar.st[1] = 0u; } __syncthreads(); xbar = xcd_barrier_post((unsigned*)(ws + WS_BAR), (volatile LAS unsigned*)(shm + LDS_BYTES - 16)); }
#define SEAM(ph) do { if ((ph) > p.ph_lo && (ph) < p.ph_hi) { if ((ph) == p.ph_lo + 1) cg::this_grid().sync(); else xcd_barrier(xbar); } } while (0)
  PHASE(0) phase_prep(p, shm);
  SEAM(1);
  PHASE(1) phase_fold(p, shm);
  SEAM(2);
  PHASE(2) { pg8::Gemm g{(const bf16_t*)((unsigned char*)p.out + OUT_XB), (const bf16_t*)(ws + WS_WIN), NTOK, PW, DM};
    pg8::StaticOrder S; S.init(g.M, g.N, ogrid(), obid()); EpiProj E{(bf16_t*)(ws + WS_PROJ), (const float*)(ws + WS_RS1)};
    pg8::gemm_phase((LAS unsigned char*)shm, g, S, E); }
  SEAM(3);
  PHASE(3) { fourier_stage1((const bf16_t*)(ws + WS_PROJ), (bf16_t*)((unsigned char*)p.out + OUT_T), shm); phase_attn(p, shm); }
  SEAM(4);
  PHASE(4) { fourier_stage2<128, 128>((const bf16_t*)((unsigned char*)p.out + OUT_T), (bf16_t*)(ws + WS_MIX), TOKP, BS, shm);
    fourier_stage2<16, 1024>((const bf16_t*)((unsigned char*)p.out + OUT_T), (bf16_t*)(ws + WS_MIX), 0, BP, shm); }
  SEAM(5);
  PHASE(5) { pg8::Gemm g{(const bf16_t*)(ws + WS_MIX), (const bf16_t*)(ws + WS_WOUT), NTOK, DM, DM};
    pg8::StaticOrder S; S.init(g.M, g.N, ogrid(), obid()); EpiOut E{p.xp, p.xs, p.out, (bf16_t*)(ws + WS_X1B), (float*)(ws + WS_SS)};
    pg8::gemm_phase((LAS unsigned char*)shm, g, S, E); }
#pragma nounroll
  for (int half = 0; half < 2; ++half) {
    const int ph1 = 6 + 2 * half, ph2 = 7 + 2 * half;
    bf16_t* actb = half ? (bf16_t*)p.out : (bf16_t*)(ws + WS_ACT);
    if (half == 0 || p.ph_hi - p.ph_lo == 1) SEAM(ph1);
    PHASE(ph1) { pg8::Gemm g{(const bf16_t*)(ws + WS_X1B) + (size_t)half * TOKP * DM, (const bf16_t*)(ws + WS_WGU), TOKP, 2 * DFF, DM};
      pg8::StaticOrder S; S.init(g.M, g.N, ogrid(), obid()); EpiFfn1 E{actb, (const float*)(ws + WS_SS), half * TOKP};
      pg8::gemm_phase((LAS unsigned char*)shm, g, S, E); }
    SEAM(ph2);
    PHASE(ph2) { pg8::Gemm g{(const bf16_t*)actb, (const bf16_t*)(ws + WS_WD), TOKP, DM, DFF};
      pg8::StaticOrder S; S.init(g.M, g.N, ogrid(), obid()); EpiFfn2 E{(bf16_t*)(ws + WS_X1B), (float*)(ws + WS_SS) + NTOK, half * TOKP};
      pg8::gemm_phase((LAS unsigned char*)shm, g, S, E); }
  }
  SEAM(10);
  PHASE(10) phase_final(p);
}

extern "C" void kernel_launch(void* const* d_in, const int* in_sizes, int n_in, void* d_out, int out_size, void* d_ws, size_t ws_size, hipStream_t stream) {
  static int grid = 0;
  if (grid == 0) {
    if (n_in != 17 || in_sizes[0] != BP * SP * DM || in_sizes[1] != BS * SS * DM || out_size != NTOK * DM || ws_size < WS_END) {
      fprintf(stderr, "kernel_launch: unexpected shapes (n_in %d, ws %zu)\n", n_in, ws_size); grid = -1; return; }
    int dev = 0, cus = 0, per_cu = 0;
    hipGetDevice(&dev); hipDeviceGetAttribute(&cus, hipDeviceAttributeMultiprocessorCount, dev);
    if (hipFuncSetAttribute((const void*)mega, hipFuncAttributeMaxDynamicSharedMemorySize, LDS_BYTES) != hipSuccess) { fprintf(stderr, "kernel_launch: hipFuncSetAttribute failed\n"); grid = -1; return; }
    if (hipOccupancyMaxActiveBlocksPerMultiprocessor(&per_cu, (const void*)mega, 512, LDS_BYTES) != hipSuccess || per_cu < 1) { fprintf(stderr, "kernel_launch: occupancy query gave %d\n", per_cu); per_cu = 1; }
    (void)hipGetLastError();
    grid = cus * 1;
  }
  if (grid < 0) return;
  Params p{};
  p.xp = (const float*)d_in[0]; p.xs = (const float*)d_in[1]; p.g1 = (const float*)d_in[2]; p.w_in = (const float*)d_in[3]; p.w_f = (const float*)d_in[4];
  p.lq1 = (const float*)d_in[5]; p.lk1 = (const float*)d_in[6]; p.lq2 = (const float*)d_in[7]; p.lk2 = (const float*)d_in[8]; p.subg = (const float*)d_in[9];
  p.w_out = (const float*)d_in[10]; p.g2 = (const float*)d_in[11]; p.w_gate = (const float*)d_in[12]; p.w_up = (const float*)d_in[13]; p.w_down = (const float*)d_in[14];
  p.relb = (const float*)d_in[15]; p.fg = (const float*)d_in[16];
  p.out = (float*)d_out; p.ws = (unsigned char*)d_ws;
#if ONE_LAUNCH
  if (hipMemsetAsync((unsigned char*)d_ws + WS_BAR, 0, XCD_BAR_WORDS * 4 + 256, stream) != hipSuccess) { fprintf(stderr, "kernel_launch: memset of the barrier words failed\n"); return; }
  p.ph_lo = 0; p.ph_hi = NPHASE;
  void* args[] = {&p};
  hipError_t e = hipLaunchCooperativeKernel((const void*)mega, dim3(grid), dim3(512), args, LDS_BYTES, stream);
  if (e != hipSuccess) fprintf(stderr, "cooperative launch failed: %s (grid %d)\n", hipGetErrorString(e), grid);
#else
  for (int ph = 0; ph < NPHASE; ++ph) { p.ph_lo = ph; p.ph_hi = ph + 1; hipLaunchKernelGGL(mega, dim3(grid), dim3(512), LDS_BYTES, stream, p); }
#endif
}
```
